# Optimizing an MI355X kernel written in HIP

```python
import math
import jax
import jax.numpy as jnp
from jax import lax
import numpy as np

D_MODEL = 2048
BATCH = 1
SEQ = 16384
DEPTH = 2

GRID_W = 64
HEAD_DIM = 128
N_FOURIER_GROUPS = 4
FOURIER_W = N_FOURIER_GROUPS * HEAD_DIM
N_NA_HEADS = 8
NA_W = N_NA_HEADS * HEAD_DIM
WIN_H = 8
WIN_W = 16
N_MEM = 256
N_MEM_HEADS = 4
MEM_W = N_MEM_HEADS * HEAD_DIM
N_BRANCHES = 3
IN_W = FOURIER_W + 3 * NA_W + MEM_W + N_BRANCHES * D_MODEL
D_FF = 5632
N_EXPERTS = 8
TOP_K = 2
MOE_BLOCK = 128
EPS = 1e-6

kernel_name = "hybrid_fourier_natten_memory_moe_encoder"


def rms_norm(x, g):
    xf = x.astype(jnp.float32)
    y = xf * lax.rsqrt(jnp.mean(xf * xf, axis=-1, keepdims=True) + EPS)
    return (y * g.astype(jnp.float32)).astype(x.dtype)


def fourier_mix(u):
    b, s, _ = u.shape
    ug = u.astype(jnp.float32).reshape(b, s, N_FOURIER_GROUPS, HEAD_DIM)
    f = jnp.fft.fft2(ug, axes=(1, 3), norm="ortho").real
    return f.reshape(b, s, FOURIER_W).astype(u.dtype)


def neighbourhood_attention(q, k, v, rpb):
    b, s, h, dh = q.shape
    rows = s // GRID_W
    kh = min(WIN_H, rows)
    cols = np.arange(GRID_W)
    col_start = np.clip(cols - WIN_W // 2, 0, GRID_W - WIN_W)
    col_idx = col_start[:, None] + np.arange(WIN_W)[None, :]
    col_off = col_idx - cols[:, None] + (WIN_W - 1)
    q_rows = jnp.moveaxis(q.reshape(b, rows, GRID_W, h, dh), 1, 0)
    k_grid = k.reshape(b, rows, GRID_W, h, dh)
    v_grid = v.reshape(b, rows, GRID_W, h, dh)
    scale = dh ** -0.5

    def row_step(args):
        r, q_r = args
        r_start = jnp.clip(r - kh // 2, 0, rows - kh)
        k_rows = lax.dynamic_slice_in_dim(k_grid, r_start, kh, axis=1)
        v_rows = lax.dynamic_slice_in_dim(v_grid, r_start, kh, axis=1)
        k_win = k_rows[:, :, col_idx]
        v_win = v_rows[:, :, col_idx]
        row_off = r_start + jnp.arange(kh) - r + (WIN_H - 1)
        bias = rpb[:, row_off][:, :, col_off]
        bias = jnp.transpose(bias, (0, 2, 1, 3)).astype(jnp.float32)
        sc = jnp.einsum('bchd,bicjhd->bhcij', q_r, k_win).astype(jnp.float32) * scale
        sc = sc + bias[None]
        p = jax.nn.softmax(sc.reshape(b, h, GRID_W, kh * WIN_W), axis=-1)
        p = p.reshape(b, h, GRID_W, kh, WIN_W).astype(v.dtype)
        return jnp.einsum('bhcij,bicjhd->bchd', p, v_win)

    out = lax.map(row_step, (jnp.arange(rows, dtype=jnp.int32), q_rows))
    return jnp.moveaxis(out, 0, 1).reshape(b, s, h * dh)


def memory_attention(q, mem_h, w_kv, q_g, k_g):
    b, s, _ = q.shape
    m = mem_h.shape[1]
    kv = mem_h @ w_kv
    k, v = jnp.split(kv, 2, axis=-1)
    q = rms_norm(q.reshape(b, s, N_MEM_HEADS, HEAD_DIM), q_g)
    k = rms_norm(k.reshape(b, m, N_MEM_HEADS, HEAD_DIM), k_g)
    v = v.reshape(b, m, N_MEM_HEADS, HEAD_DIM)
    sc = jnp.einsum('bshd,bmhd->bhsm', q, k).astype(jnp.float32) * (HEAD_DIM ** -0.5)
    p = jax.nn.softmax(sc, axis=-1).astype(v.dtype)
    o = jnp.einsum('bhsm,bmhd->bshd', p, v)
    return o.reshape(b, s, MEM_W)


def swiglu(h, w_gate, w_up, w_down):
    return (jax.nn.silu(h @ w_gate) * (h @ w_up)) @ w_down


def moe_swiglu(h, w_router, w_gate, w_up, w_down):
    b, s, d = h.shape
    n = b * s
    hf = h.reshape(n, d)
    logits = (hf @ w_router).astype(jnp.float32)
    top_logit, top_e = lax.top_k(logits, TOP_K)
    gates = jax.nn.softmax(top_logit, axis=-1)
    e_flat = top_e.reshape(-1)
    t_flat = jnp.repeat(jnp.arange(n, dtype=jnp.int32), TOP_K)
    w_flat = gates.reshape(-1)
    order = jnp.argsort(e_flat)
    e_sorted = e_flat[order]
    counts = jnp.bincount(e_flat, length=N_EXPERTS)
    starts = jnp.cumsum(counts) - counts
    padded = (counts + MOE_BLOCK - 1) // MOE_BLOCK * MOE_BLOCK
    pad_ends = jnp.cumsum(padded)
    pad_starts = pad_ends - padded
    n_assign = n * TOP_K
    dest = pad_starts[e_sorted] + jnp.arange(n_assign) - starts[e_sorted]
    cap = n_assign + N_EXPERTS * MOE_BLOCK
    n_blocks = cap // MOE_BLOCK
    tok_buf = jnp.full((cap,), n, jnp.int32).at[dest].set(t_flat[order])
    wt_buf = jnp.zeros((cap,), jnp.float32).at[dest].set(w_flat[order])
    blk_e = jnp.clip(jnp.searchsorted(pad_ends, jnp.arange(n_blocks) * MOE_BLOCK, side='right'),
                     0, N_EXPERTS - 1)
    x_pad = jnp.concatenate([hf, jnp.zeros((1, d), hf.dtype)], axis=0)
    xb = x_pad[tok_buf].reshape(n_blocks, MOE_BLOCK, d)

    def expert_block(args):
        xblk, e = args
        return swiglu(xblk, w_gate[e], w_up[e], w_down[e])

    yb = lax.map(expert_block, (xb, blk_e)).reshape(cap, d)
    y = jnp.zeros((n + 1, d), jnp.float32).at[tok_buf].add(yb.astype(jnp.float32) * wt_buf[:, None])
    return y[:n].reshape(b, s, d).astype(h.dtype)


def setup_inputs(seed: int = 0) -> dict:
    key = jax.random.key(seed)
    ks = jax.random.split(key, 24)
    L = DEPTH
    n_dense = (DEPTH + 1) // 2
    n_moe = DEPTH // 2
    f32 = jnp.float32

    def nrm(k, shape, scale):
        return jax.random.normal(k, shape, f32) * scale

    def gain(k, shape):
        return 1.0 + 0.02 * jax.random.normal(k, shape, f32)

    return {
        "x": nrm(ks[0], (BATCH, SEQ, D_MODEL), 1.0),
        "mem": nrm(ks[1], (BATCH, N_MEM, D_MODEL), 1.0),
        "ln_mix_g": gain(ks[2], (L, D_MODEL)),
        "w_in": nrm(ks[3], (L, D_MODEL, IN_W), D_MODEL ** -0.5),
        "na_q_g": gain(ks[4], (L, HEAD_DIM)),
        "na_k_g": gain(ks[5], (L, HEAD_DIM)),
        "na_rpb": nrm(ks[6], (L, N_NA_HEADS, 2 * WIN_H - 1, 2 * WIN_W - 1), 0.02),
        "mem_ln_g": gain(ks[7], (L, D_MODEL)),
        "w_mem_kv": nrm(ks[8], (L, D_MODEL, 2 * MEM_W), D_MODEL ** -0.5),
        "mem_q_g": gain(ks[9], (L, HEAD_DIM)),
        "mem_k_g": gain(ks[10], (L, HEAD_DIM)),
        "w_fourier_out": nrm(ks[11], (L, FOURIER_W, D_MODEL), FOURIER_W ** -0.5),
        "w_na_out": nrm(ks[12], (L, NA_W, D_MODEL), NA_W ** -0.5),
        "w_mem_out": nrm(ks[13], (L, MEM_W, D_MODEL), MEM_W ** -0.5),
        "w_o": nrm(ks[14], (L, D_MODEL, D_MODEL), D_MODEL ** -0.5),
        "ln_ffn_g": gain(ks[15], (L, D_MODEL)),
        "ffn_w_gate": nrm(ks[16], (n_dense, D_MODEL, D_FF), D_MODEL ** -0.5),
        "ffn_w_up": nrm(ks[17], (n_dense, D_MODEL, D_FF), D_MODEL ** -0.5),
        "ffn_w_down": nrm(ks[18], (n_dense, D_FF, D_MODEL), D_FF ** -0.5),
        "moe_router": nrm(ks[19], (n_moe, D_MODEL, N_EXPERTS), D_MODEL ** -0.5),
        "moe_w_gate": nrm(ks[20], (n_moe, N_EXPERTS, D_MODEL, D_FF), D_MODEL ** -0.5),
        "moe_w_up": nrm(ks[21], (n_moe, N_EXPERTS, D_MODEL, D_FF), D_MODEL ** -0.5),
        "moe_w_down": nrm(ks[22], (n_moe, N_EXPERTS, D_FF, D_MODEL), D_FF ** -0.5),
    }


def reference(x, mem, ln_mix_g, w_in, na_q_g, na_k_g, na_rpb, mem_ln_g, w_mem_kv,
              mem_q_g, mem_k_g, w_fourier_out, w_na_out, w_mem_out, w_o, ln_ffn_g,
              ffn_w_gate, ffn_w_up, ffn_w_down, moe_router, moe_w_gate, moe_w_up,
              moe_w_down):
    b, s, d = x.shape
    splits = [FOURIER_W,
              FOURIER_W + NA_W,
              FOURIER_W + 2 * NA_W,
              FOURIER_W + 3 * NA_W,
              FOURIER_W + 3 * NA_W + MEM_W]
    for l in range(DEPTH):
        h = rms_norm(x, ln_mix_g[l])
        proj = h @ w_in[l]
        f_in, q_na, k_na, v_na, q_mem, gate_logits = jnp.split(proj, splits, axis=-1)

        o_f = fourier_mix(f_in) @ w_fourier_out[l]

        q_na = rms_norm(q_na.reshape(b, s, N_NA_HEADS, HEAD_DIM), na_q_g[l])
        k_na = rms_norm(k_na.reshape(b, s, N_NA_HEADS, HEAD_DIM), na_k_g[l])
        v_na = v_na.reshape(b, s, N_NA_HEADS, HEAD_DIM)
        o_n = neighbourhood_attention(q_na, k_na, v_na, na_rpb[l]) @ w_na_out[l]

        mem_h = rms_norm(mem, mem_ln_g[l])
        o_m = memory_attention(q_mem, mem_h, w_mem_kv[l], mem_q_g[l], mem_k_g[l]) @ w_mem_out[l]

        g = jax.nn.sigmoid(gate_logits.astype(jnp.float32)).astype(x.dtype)
        g = g.reshape(b, s, N_BRANCHES, d)
        merged = g[:, :, 0] * o_f + g[:, :, 1] * o_n + g[:, :, 2] * o_m
        x = x + merged @ w_o[l]

        h2 = rms_norm(x, ln_ffn_g[l])
        if l % 2 == 0:
            i = l // 2
            y = swiglu(h2, ffn_w_gate[i], ffn_w_up[i], ffn_w_down[i])
        else:
            i = l // 2
            y = moe_swiglu(h2, moe_router[i], moe_w_gate[i], moe_w_up[i], moe_w_down[i])
        x = x + y
    return x
```

```cpp
#include <hip/hip_runtime.h>
#include <cstdio>
#include <cstdint>

typedef unsigned short bf16;
typedef short bf16x8 __attribute__((ext_vector_type(8)));
typedef float f32x4 __attribute__((ext_vector_type(4)));
typedef float f32x16 __attribute__((ext_vector_type(16)));
typedef unsigned u32x4 __attribute__((ext_vector_type(4)));
typedef unsigned u32x2 __attribute__((ext_vector_type(2)));

constexpr int S = 16384, D = 2048, GW = 64, ROWS = 256, HD = 128;
constexpr int NMEM = 256;
constexpr int INW = 10240;
constexpr int DFF = 5632, NE = 8;
constexpr int NMAIN = 8704;
constexpr int NT = 1536;
constexpr float EPS = 1e-6f;
constexpr float LOG2E = 1.4426950408889634f;
constexpr float QSCALE = 0.08838834764831845f * LOG2E;
constexpr int CAP = 16384;
constexpr int HROWS = 2 * S + NE * 256;

constexpr size_t MiB = 1u << 20;
constexpr size_t OFF_CTL = 0;
constexpr size_t OFF_DFTC = 1 * MiB;
constexpr size_t OFF_DFTS = OFF_DFTC + 32768;
constexpr size_t OFF_TW = OFF_DFTS + 32768;
constexpr size_t OFF_CS128 = OFF_TW + 131072;
constexpr size_t OFF_RPBP = MiB + 524288;
constexpr size_t OFF_KMEM = 2 * MiB;
constexpr size_t OFF_VMEMT = OFF_KMEM + 524288;
constexpr size_t OFF_TOKL = 3 * MiB;
constexpr size_t OFF_WTL = OFF_TOKL + 524288;
constexpr size_t OFF_RSTOK = OFF_WTL + 524288;
constexpr size_t OFF_TOKSLOT = OFF_RSTOK + 131072;
constexpr size_t OFF_TOKW = OFF_TOKSLOT + 131072;
constexpr size_t OFF_RSX = 5 * MiB;
constexpr size_t OFF_XSS = 6 * MiB;
constexpr size_t OFF_XSS2 = 8 * MiB;
constexpr size_t OFF_W = 10 * MiB;
constexpr size_t SZ_WINM = (size_t)NMAIN * D * 2, SZ_WINT = (size_t)NT * D * 2, SZ_WFO2 = (size_t)D * 1024 * 2, SZ_WNA = (size_t)D * 1024 * 2,
                 SZ_WMO = (size_t)D * 512 * 2, SZ_WO = (size_t)D * D * 2, SZ_WGU = (size_t)2 * DFF * D * 2, SZ_WD = (size_t)D * DFF * 2;
constexpr size_t OFF_WINM = OFF_W;
constexpr size_t OFF_WINT = OFF_WINM + 2 * SZ_WINM;
constexpr size_t OFF_WFO2 = OFF_WINT + 2 * SZ_WINT;
constexpr size_t OFF_WNA = OFF_WFO2 + 2 * SZ_WFO2;
constexpr size_t OFF_WMO = OFF_WNA + 2 * SZ_WNA;
constexpr size_t OFF_WO = OFF_WMO + 2 * SZ_WMO;
constexpr size_t OFF_WGU0 = OFF_WO + 2 * SZ_WO;
constexpr size_t OFF_WD0 = OFF_WGU0 + SZ_WGU;
constexpr size_t OFF_WGUE = OFF_WD0 + SZ_WD;
constexpr size_t OFF_WDE = OFF_WGUE + 8 * SZ_WGU;
constexpr size_t OFF_WEND = OFF_WDE + 8 * SZ_WD;
constexpr size_t OFF_XB = (OFF_WEND + MiB - 1) / MiB * MiB;
constexpr size_t OFF_ACT = OFF_XB + (size_t)S * D * 2;
constexpr size_t OFF_QN = OFF_ACT;
constexpr size_t OFF_KN = OFF_QN + (size_t)S * 1024 * 2;
constexpr size_t OFF_VT = OFF_KN + (size_t)S * 1024 * 2;
constexpr size_t OFF_QM = OFF_VT + (size_t)S * 1024 * 2;
constexpr size_t OFF_GT = OFF_QM + (size_t)S * 512 * 2;
constexpr size_t OFF_FINT = OFF_GT + (size_t)S * 6144 * 2;
constexpr size_t OFF_B2P = OFF_FINT + (size_t)S * 512 * 2;
constexpr size_t OFF_B2Q = OFF_B2P + (size_t)S * 512 * 2;
constexpr size_t OFF_YM = OFF_B2Q + (size_t)S * 512 * 2;
constexpr size_t OFF_ONA = OFF_YM + (size_t)S * 1024 * 2;
constexpr size_t OFF_OMEM = OFF_ONA + (size_t)S * 1024 * 2;
constexpr size_t OFF_MPART = OFF_OMEM + (size_t)S * 512 * 2;
constexpr size_t OFF_MG = OFF_MPART + (size_t)S * D * 4;
constexpr size_t OFF_ACTEND = OFF_MG + (size_t)S * D * 2;
constexpr size_t OFF_HMID = OFF_ACT;
static_assert(OFF_HMID + (size_t)HROWS * DFF * 2 <= OFF_ACTEND, "hmid overlay");
constexpr size_t OFF_YBUF = OFF_HMID + (size_t)HROWS * DFF * 2;
static_assert(OFF_YBUF + (size_t)HROWS * D * 2 <= OFF_ACTEND, "ybuf");
constexpr size_t OFF_XB8 = OFF_ACTEND;
constexpr size_t OFF_WG8 = (size_t)2560 * D * 2;
static_assert(OFF_WG8 + (size_t)6144 * D <= SZ_WINM, "gate weights");
constexpr size_t WS_NEED = OFF_XB8 + (size_t)S * D;
constexpr size_t OFF_ACTM = OFF_YM;
constexpr int LDM = 2560;
constexpr size_t OFF_WALL = OFF_WFO2;
constexpr size_t SZ_WALL = (size_t)D * LDM * 2;
static_assert(OFF_ACTM + (size_t)S * LDM * 2 == OFF_MPART && OFF_WALL + 2 * SZ_WALL == OFF_WO, "combined out-proj operands");
constexpr int CW_CNT = 64;

struct Params { const float* in[23]; float* out; unsigned char* ws; };

__device__ __forceinline__ unsigned f2bf(float f) { unsigned u = __float_as_uint(f); return (u + 0x7fffu + ((u >> 16) & 1u)) >> 16; }
__device__ __forceinline__ unsigned pk2(float lo, float hi) { return f2bf(lo) | (f2bf(hi) << 16); }
__device__ __forceinline__ unsigned pk2hw(float lo, float hi) { unsigned r; asm("s_nop 1\n\tv_cvt_pk_bf16_f32 %0, %1, %2" : "=v"(r) : "v"(lo), "v"(hi)); return r; }
__device__ __forceinline__ float bf2f(unsigned b) { return __uint_as_float(b << 16); }
__device__ __forceinline__ int lane_id_() { int l; asm volatile("v_mbcnt_lo_u32_b32 %0, -1, 0\n\tv_mbcnt_hi_u32_b32 %0, -1, %0" : "=v"(l)); return l; }
__device__ __forceinline__ int zero_i_() { int z; asm volatile("v_mov_b32 %0, 0" : "=v"(z)); return z; }
__device__ __forceinline__ float zero_f_() { float z; asm volatile("v_mov_b32 %0, 0" : "=v"(z)); return z; }
__device__ __forceinline__ float shflx(float v, int k) { return __int_as_float(__builtin_amdgcn_ds_bpermute((lane_id_() ^ k) << 2, __float_as_int(v))); }
__device__ __forceinline__ float wave_sum(float v) {
#pragma unroll
    for (int o = 1; o < 64; o <<= 1) v += shflx(v, o);
    return v;
}
__device__ __forceinline__ float sigmoidf_(float z) { return __builtin_amdgcn_rcpf(1.f + __builtin_amdgcn_exp2f(-1.4426950408889634f * z)); }
__device__ __forceinline__ f32x4 sigmoid4_(const f32x4 z) { f32x4 t;
#pragma unroll
    for (int q = 0; q < 4; ++q) t[q] = __builtin_amdgcn_exp2f(-1.4426950408889634f * z[q]);
#pragma unroll
    for (int q = 0; q < 4; ++q) t[q] = 1.f + t[q];
#pragma unroll
    for (int q = 0; q < 4; ++q) t[q] = __builtin_amdgcn_rcpf(t[q]);
    return t; }
#define LDS_WAIT() asm volatile("s_waitcnt lgkmcnt(0)" ::: "memory")

struct TrLoad { f32x4 v[8]; };
__device__ __forceinline__ void transpose_load(const float* W, int N, int item, int lane, TrLoad& t) {
    const int nblk = N / 32, kb = item / nblk, nb = item % nblk, k0 = 64 * kb, n0 = 32 * nb;
    const float* src = W + (size_t)(k0 + (lane >> 3)) * N + n0 + 4 * (lane & 7);
#pragma unroll
    for (int i = 0; i < 8; ++i) t.v[i] = *(const f32x4*)(src + (size_t)(8 * i) * N);
}
__device__ __forceinline__ void transpose_load4(const float* W, int N, int item4, int lane, TrLoad (&t)[4]) {
    const int nblk4 = N / 128, kb = item4 / nblk4, nb4 = item4 % nblk4, k0 = 64 * kb, n0 = 128 * nb4;
    const float* src = W + (size_t)(k0 + (lane >> 3)) * N + n0 + 4 * (lane & 7);
#pragma unroll
    for (int sb = 0; sb < 4; ++sb)
#pragma unroll
        for (int i = 0; i < 8; ++i) t[sb].v[i] = *(const f32x4*)(src + (size_t)(8 * i) * N + 32 * sb);
}
template <int MODE>
__device__ __forceinline__ void transpose_finish(const TrLoad& t, int K, int N, const float* gain, bf16* dst, bf16* dst2, float* scr, int item, int lane, int ldk = 0, int koff = 0) {
    if (ldk == 0) ldk = K;
    const int nblk = N / 32, kb = item / nblk, nb = item % nblk, k0 = 64 * kb, n0 = 32 * nb;
#pragma unroll
    for (int i = 0; i < 8; ++i) { const int kk = 8 * i + (lane >> 3); f32x4 v = t.v[i]; if (gain) v = v * gain[k0 + kk]; float* s = scr + kk * 33 + 4 * (lane & 7); s[0] = v[0]; s[1] = v[1]; s[2] = v[2]; s[3] = v[3]; }
    LDS_WAIT();
    const int c = lane & 7;
#pragma unroll
    for (int j = 0; j < 4; ++j) { const int n = (lane >> 3) + 8 * j; const float* s = scr + (8 * c) * 33 + n;
        u32x4 o; o.x = pk2hw(s[0 * 33], s[1 * 33]); o.y = pk2hw(s[2 * 33], s[3 * 33]); o.z = pk2hw(s[4 * 33], s[5 * 33]); o.w = pk2hw(s[6 * 33], s[7 * 33]);
        bf16* base = dst; int row; const int nn = n0 + n;
        if (MODE == 0) row = nn;
        else if (MODE == 1) {
            if (nn < 512) { base = dst2; row = 1024 + nn; }
            else if (nn < 1536) { row = nn - 512; }
            else if (nn < 2560) { row = 1024 + (nn - 1536); }
            else if (nn < 3584) { base = dst2; row = nn - 2560; }
            else if (nn < 4096) { row = 2048 + (nn - 3584); }
            else { row = 2560 + (nn - 4096); } }
        else { row = 8 * (nn >> 2) + (nn & 3) + (MODE == 3 ? 4 : 0); }
        *(u32x4*)(base + (size_t)row * ldk + koff + k0 + 8 * c) = o; }
    LDS_WAIT();
}
template <int MODE>
__device__ __forceinline__ void transpose_finish8(const TrLoad& t, int K, int N, const float* gain, float scale, unsigned char* dst, float* scr, int item, int lane) {
    const int nblk = N / 32, kb = item / nblk, nb = item % nblk, k0 = 64 * kb, n0 = 32 * nb;
#pragma unroll
    for (int i = 0; i < 8; ++i) { const int kk = 8 * i + (lane >> 3); f32x4 v = t.v[i] * scale; if (gain) v = v * gain[k0 + kk]; float* s = scr + kk * 33 + 4 * (lane & 7); s[0] = v[0]; s[1] = v[1]; s[2] = v[2]; s[3] = v[3]; }
    LDS_WAIT();
    const int c = lane & 7;
#pragma unroll
    for (int j = 0; j < 4; ++j) { const int n = (lane >> 3) + 8 * j; const float* s = scr + (8 * c) * 33 + n;
        int w0 = 0, w1 = 0;
        w0 = __builtin_amdgcn_cvt_pk_fp8_f32(s[0 * 33], s[1 * 33], w0, false); w0 = __builtin_amdgcn_cvt_pk_fp8_f32(s[2 * 33], s[3 * 33], w0, true);
        w1 = __builtin_amdgcn_cvt_pk_fp8_f32(s[4 * 33], s[5 * 33], w1, false); w1 = __builtin_amdgcn_cvt_pk_fp8_f32(s[6 * 33], s[7 * 33], w1, true);
        const int nn = n0 + n; const int row = (MODE == 0) ? nn : (MODE == 4) ? (nn - 4096) : (MODE == 5) ? (nn - 2560) : (MODE == 6) ? (nn < 2560 ? nn - 512 : nn - 1536) : (8 * (nn >> 2) + (nn & 3) + (MODE == 3 ? 4 : 0));
        u32x2 o; o.x = (unsigned)w0; o.y = (unsigned)w1; *(u32x2*)(dst + (size_t)row * K + k0 + 8 * c) = o; }
    LDS_WAIT();
}
__device__ __forceinline__ int prow32(int r) { return (r & ~12) | ((r & 4) << 1) | ((r & 8) >> 1); }
template <bool NA>
__device__ __forceinline__ void attn_wave_f(const bf16* Q, int qs, const bf16* KF, const bf16* VF, int T0, int ntiles, const float* rpb, int qrow, int rstart, int chalf, bf16* O, int os, int lane) {
    const int r = lane & 31, h = lane >> 5;
    bf16x8 qf[8];
#pragma unroll
    for (int s = 0; s < 8; ++s) qf[s] = *(const bf16x8*)(Q + (size_t)r * qs + 16 * s + 8 * h);
    f32x16 o[4];
#pragma unroll
    for (int d = 0; d < 4; ++d)
#pragma unroll
        for (int q = 0; q < 16; ++q) o[d][q] = 0.f;
    float m = -3.0e38f, lsum = 0.f;
    const int c = chalf * 32 + r; const int cs = c - 8 < 0 ? 0 : (c - 8 > 48 ? 48 : c - 8);
    const bf16* kp = KF + (size_t)T0 * 4096 + lane * 8; const bf16* vp = VF + (size_t)T0 * 4096 + lane * 8;
    bf16x8 kf[8];
#pragma unroll
    for (int s = 0; s < 8; ++s) kf[s] = *(const bf16x8*)(kp + s * 512);
    for (int t = 0; t < ntiles; ++t) {
        bf16x8 vf[4][2];
#pragma unroll
        for (int d = 0; d < 4; ++d)
#pragma unroll
            for (int s = 0; s < 2; ++s) vf[d][s] = *(const bf16x8*)(vp + (size_t)t * 4096 + (d * 2 + s) * 512);
        float bvv[16];
        if (NA) { const int ro = rstart + (t >> 1) - qrow + 7; const float* bp = rpb + ro * 128 + (48 + 15 + 32 * (t & 1) + 8 * h - c);
#pragma unroll
            for (int q = 0; q < 16; ++q) bvv[q] = bp[16 * (q >> 3) + (q & 7)]; }
        f32x16 sacc;
#pragma unroll
        for (int q = 0; q < 16; ++q) sacc[q] = 0.f;
#pragma unroll
        for (int s = 0; s < 8; ++s) sacc = __builtin_amdgcn_mfma_f32_32x32x16_bf16(kf[s], qf[s], sacc, 0, 0, 0);
        if (NA) {
            asm volatile("" : "+v"(bvv[0]), "+v"(bvv[1]), "+v"(bvv[2]), "+v"(bvv[3]), "+v"(bvv[4]), "+v"(bvv[5]), "+v"(bvv[6]), "+v"(bvv[7]));
            asm volatile("" : "+v"(bvv[8]), "+v"(bvv[9]), "+v"(bvv[10]), "+v"(bvv[11]), "+v"(bvv[12]), "+v"(bvv[13]), "+v"(bvv[14]), "+v"(bvv[15]));
            const int bk = 32 * (t & 1) + 8 * h - cs;
#pragma unroll
            for (int q = 0; q < 16; ++q) { const bool ok = (unsigned)(bk + 16 * (q >> 3) + (q & 7)) < 16u;
                sacc[q] = ok ? sacc[q] + bvv[q] : -1.0e30f; } }
        { const int tn = t + 1 < ntiles ? t + 1 : t;
#pragma unroll
          for (int s = 0; s < 8; ++s) kf[s] = *(const bf16x8*)(kp + (size_t)tn * 4096 + s * 512); }
        float tmax = -3.0e38f;
#pragma unroll
        for (int q = 0; q < 16; ++q) tmax = fmaxf(tmax, sacc[q]);
        tmax = fmaxf(tmax, shflx(tmax, 32));
        const float mn = fmaxf(m, tmax); const float alpha = __builtin_amdgcn_exp2f(m - mn); m = mn;
        float ps = 0.f;
#pragma unroll
        for (int q = 0; q < 16; ++q) { sacc[q] = __builtin_amdgcn_exp2f(sacc[q] - mn); ps += sacc[q]; }
        lsum = lsum * alpha + ps;
#pragma unroll
        for (int d = 0; d < 4; ++d)
#pragma unroll
            for (int q = 0; q < 16; ++q) o[d][q] *= alpha;
        bf16x8 pf[2];
#pragma unroll
        for (int s = 0; s < 2; ++s) { u32x4 w; w.x = pk2(sacc[8 * s], sacc[8 * s + 1]); w.y = pk2(sacc[8 * s + 2], sacc[8 * s + 3]); w.z = pk2(sacc[8 * s + 4], sacc[8 * s + 5]); w.w = pk2(sacc[8 * s + 6], sacc[8 * s + 7]); pf[s] = __builtin_bit_cast(bf16x8, w); }
#pragma unroll
        for (int d = 0; d < 4; ++d)
#pragma unroll
            for (int s = 0; s < 2; ++s) o[d] = __builtin_amdgcn_mfma_f32_32x32x16_bf16(vf[d][s], pf[s], o[d], 0, 0, 0);
    }
    lsum += shflx(lsum, 32); const float inv = 1.f / lsum;
#pragma unroll
    for (int d = 0; d < 4; ++d)
#pragma unroll
        for (int q = 0; q < 4; ++q) { u32x2 w; w.x = pk2(o[d][4 * q] * inv, o[d][4 * q + 1] * inv); w.y = pk2(o[d][4 * q + 2] * inv, o[d][4 * q + 3] * inv);
            *(u32x2*)(O + (size_t)r * os + 32 * d + 8 * q + 4 * h) = w; }
}
__device__ __forceinline__ void f1_wave(const bf16* finT, const bf16* dC, const bf16* dS, const float* tw, bf16* B2P, bf16* B2Q, int rb, int lane) {
    const int r = lane & 31, h = lane >> 5; const int R0 = rb * 32, c = R0 >> 7, sf0 = R0 & 127;
    bf16x8 xf[8];
#pragma unroll
    for (int s = 0; s < 8; ++s) xf[s] = *(const bf16x8*)(finT + (size_t)(R0 + r) * 128 + 16 * s + 8 * h);
    for (int cb = 0; cb < 4; ++cb) { const int kb = cb * 32 + r;
        f32x16 ar, as;
#pragma unroll
        for (int q = 0; q < 16; ++q) { ar[q] = 0.f; as[q] = 0.f; }
#pragma unroll
        for (int s = 0; s < 8; ++s) { const bf16x8 cf = *(const bf16x8*)(dC + kb * 128 + 16 * s + 8 * h), sf = *(const bf16x8*)(dS + kb * 128 + 16 * s + 8 * h);
            ar = __builtin_amdgcn_mfma_f32_32x32x16_bf16(xf[s], cf, ar, 0, 0, 0); as = __builtin_amdgcn_mfma_f32_32x32x16_bf16(xf[s], sf, as, 0, 0, 0); }
#pragma unroll
        for (int qq = 0; qq < 4; ++qq) { float pv[4], qv[4];
#pragma unroll
            for (int e = 0; e < 4; ++e) { const int sf = sf0 + e + 8 * qq + 4 * h; const float2 t = *(const float2*)(tw + 2 * (kb * sf)); const float a = ar[4 * qq + e], b = as[4 * qq + e];
                pv[e] = t.x * a - t.y * b; qv[e] = t.x * b + t.y * a; }
            const size_t off = ((size_t)kb * 512 + c) * 128 + sf0 + 8 * qq + 4 * h;
            u32x2 w; w.x = pk2(pv[0], pv[1]); w.y = pk2(pv[2], pv[3]); *(u32x2*)(B2P + off) = w; w.x = pk2(qv[0], qv[1]); w.y = pk2(qv[2], qv[3]); *(u32x2*)(B2Q + off) = w; }
    }
}
__device__ __forceinline__ void f2_wave(const bf16* B2P, const bf16* B2Q, const bf16* dC, const bf16* dS, bf16* Ym, int rb, int lane, int ldy = 1024) {
    const int r = lane & 31, h = lane >> 5; const int R0 = rb * 32, kb = R0 >> 9, c0 = R0 & 511;
    bf16x8 pf[8], qf[8];
#pragma unroll
    for (int s = 0; s < 8; ++s) { pf[s] = *(const bf16x8*)(B2P + (size_t)(R0 + r) * 128 + 16 * s + 8 * h); qf[s] = *(const bf16x8*)(B2Q + (size_t)(R0 + r) * 128 + 16 * s + 8 * h); }
    for (int cb = 0; cb < 4; ++cb) { const int ka = cb * 32 + r;
        f32x16 yr, z;
#pragma unroll
        for (int q = 0; q < 16; ++q) { yr[q] = 0.f; z[q] = 0.f; }
#pragma unroll
        for (int s = 0; s < 8; ++s) { const bf16x8 sf = *(const bf16x8*)(dS + ka * 128 + 16 * s + 8 * h); yr = __builtin_amdgcn_mfma_f32_32x32x16_bf16(qf[s], sf, yr, 0, 0, 0); z = __builtin_amdgcn_mfma_f32_32x32x16_bf16(pf[s], sf, z, 0, 0, 0); }
#pragma unroll
        for (int q = 0; q < 16; ++q) yr[q] = -yr[q];
#pragma unroll
        for (int s = 0; s < 8; ++s) { const bf16x8 cf = *(const bf16x8*)(dC + ka * 128 + 16 * s + 8 * h); yr = __builtin_amdgcn_mfma_f32_32x32x16_bf16(pf[s], cf, yr, 0, 0, 0); z = __builtin_amdgcn_mfma_f32_32x32x16_bf16(qf[s], cf, z, 0, 0, 0); }
        const size_t tok = (size_t)128 * ka + kb;
#pragma unroll
        for (int qq = 0; qq < 4; ++qq) { const int cc = c0 + 8 * qq + 4 * h; u32x2 w;
            w.x = pk2(yr[4 * qq], yr[4 * qq + 1]); w.y = pk2(yr[4 * qq + 2], yr[4 * qq + 3]); *(u32x2*)(Ym + tok * ldy + cc) = w;
            w.x = pk2(z[4 * qq], z[4 * qq + 1]); w.y = pk2(z[4 * qq + 2], z[4 * qq + 3]); *(u32x2*)(Ym + tok * ldy + 512 + cc) = w; }
    }
}

#define LAS __attribute__((address_space(3)))
#define GAS __attribute__((address_space(1)))
#define VM_WAIT() asm volatile("s_waitcnt vmcnt(0)" ::: "memory")

#ifndef WO8_LAYER
#define WO8_LAYER -1
#endif
constexpr int RING_BYTES = 131072;
constexpr int L_MISC = RING_BYTES;
constexpr int L_RS = RING_BYTES + 256;
constexpr int L_SS = L_RS + 1024;
constexpr int L_MOE = L_SS + 8192;
constexpr int L_SL2 = 147456;
constexpr int LDS_BYTES = 147456 + 8192;
static_assert(L_MOE + 1024 <= LDS_BYTES, "LDS map");

#define TID_OF(wv) ((wv) * 64 + lane_id_())
namespace pg8 {
typedef int v8i32 __attribute__((ext_vector_type(8)));
typedef int i32x4 __attribute__((ext_vector_type(4)));
constexpr int BM = 256, BK = 64, HALF = 128, HTB = HALF * BK * 2, STAGE_BYTES = 8 * HTB, NXCD = 8, WGM = 8;
__host__ __device__ __forceinline__ int lds_byte(int r, int c) { const int st = (r >> 4) * 2 + (c >> 5), rr = r & 15, cc = c & 31, ob = rr * 64 + cc * 2; return st * 1024 + (ob ^ (((ob >> 9) & 1) << 5)); }
__host__ __device__ __forceinline__ void stage_rc(int b, int& R, int& C) { const int st = b / 1024, sb = b % 1024, swz = sb ^ (((sb >> 9) & 1) << 5); R = (st >> 1) * 16 + swz / 64; C = (st & 1) * 32 + (swz % 64) / 2; }
__host__ __device__ __forceinline__ int perm32(int rho) { const int n = rho >> 4, i = rho & 15; return 8 * (i >> 2) + 4 * n + (i & 3); }
__device__ __forceinline__ unsigned cvt_pk_bf16(float lo, float hi) { unsigned r; asm volatile("s_nop 1\n\tv_cvt_pk_bf16_f32 %0, %1, %2" : "=v"(r) : "v"(lo), "v"(hi)); return r; }

struct Unit { int pm, pn, e, rows; };

__device__ __forceinline__ bool static_unit(int i, int G, int c, int nM, int nN, int& pm, int& pn) {
    const int nwg = nM * nN; const long L = (long)i * G + c; if (L >= nwg) return false;
    int wgid = (int)L; { const int q = nwg / NXCD, r = nwg % NXCD, xcd = wgid % NXCD, off = wgid / NXCD; wgid = (xcd < r ? xcd * (q + 1) : r * (q + 1) + (xcd - r) * q) + off; }
    const int nig = WGM * nN, gid = wgid / nig, fm = gid * WGM, gsz = (nM - fm) < WGM ? (nM - fm) : WGM;
    pm = fm + ((wgid % nig) % gsz); pn = (wgid % nig) / gsz; return true;
}
template <int MODE> struct Sched {
    static constexpr bool GATHER = (MODE == 2); static constexpr int MODE_ = MODE;
    const char* A; const char* Bt; int K; unsigned a_rs, b_rs;
    int nM, nN, G, c;
    const int* tokl; size_t b_estride;
    const LAS int* mt;
    __device__ __forceinline__ bool next(int i, Unit& u) const {
        int pm, pn; const int nm = (MODE >= 2) ? __builtin_amdgcn_readfirstlane(mt[8]) : nM;
        if (!static_unit(i, G, c, nm, nN, pm, pn)) return false;
        u.pm = pm; u.pn = pn; u.e = 0; u.rows = 256;
        if (MODE >= 2) { const int e = __builtin_amdgcn_readfirstlane(mt[32 + pm]); const int ts = __builtin_amdgcn_readfirstlane(mt[9 + e]); const int cn = __builtin_amdgcn_readfirstlane(mt[e]);
            u.e = e; const int j = pm - ts; const int rem = cn - 256 * j; u.rows = rem < 256 ? rem : 256; u.pm = pm; u.pn = pn; u.e = e | (j << 8); }
        return true; }
    __device__ __forceinline__ const char* a_base(const Unit& u) const { if (MODE == 2) return A; return A + (size_t)u.pm * 256 * a_rs * 2; }
    __device__ __forceinline__ const char* b_base(const Unit& u) const {
        if (MODE == 1) return Bt + (size_t)(2 * u.pn) * b_rs * 2;
        if (MODE >= 2) return Bt + (size_t)(u.e & 255) * b_estride + (size_t)u.pn * 256 * b_rs * 2;
        return Bt + (size_t)u.pn * 256 * b_rs * 2; }
    __device__ __forceinline__ unsigned b_off(int R, int C) const { if (MODE == 1) return (unsigned)((128 * R * b_rs + C) * 2u); return (unsigned)((R * b_rs + C) * 2u); }
    __device__ __forceinline__ size_t b_hstep() const { return MODE == 1 ? (size_t)b_rs * 2 : (size_t)128 * b_rs * 2; }
    __device__ __forceinline__ size_t a_hstep() const { return GATHER ? 0 : (size_t)128 * a_rs * 2; }
    __device__ __forceinline__ void a_offsets(const Unit& u, int tid, unsigned (&v)[2][2]) const {
        int R[2], C[2];
#pragma unroll
        for (int i = 0; i < 2; ++i) stage_rc(tid * 16 + i * 8192, R[i], C[i]);
#pragma unroll
        for (int h = 0; h < 2; ++h)
#pragma unroll
            for (int i = 0; i < 2; ++i) {
                if (MODE == 2) { const int e = u.e & 255, j = u.e >> 8; int slot = 256 * j + 128 * h + R[i]; const int cn = mt[e]; if (slot >= cn) slot = 0; const int t = tokl[e * CAP + slot]; v[h][i] = (unsigned)((t * a_rs + C[i]) * 2u); }
                else v[h][i] = (unsigned)((R[i] * a_rs + C[i]) * 2u); } }
};

typedef __amdgpu_buffer_rsrc_t rsrc_raw_t;
struct rsrc_t { rsrc_raw_t r; const char* p; };
template <bool USE_BUF> __device__ __forceinline__ rsrc_t mk_rsrc(const char* p) { rsrc_t o; o.p = p; if constexpr (!USE_BUF) { o.r = rsrc_raw_t(); return o; }
    const unsigned long long v = (unsigned long long)p; const unsigned lo = __builtin_amdgcn_readfirstlane((unsigned)v), hi = __builtin_amdgcn_readfirstlane((unsigned)(v >> 32));
    o.r = __builtin_amdgcn_make_buffer_rsrc((void*)(((unsigned long long)hi << 32) | lo), 0, 0xFFFFFFFF, 0x00020000); return o;
}
template <class Epi, class SchedT>
__device__ __forceinline__ void gemm_phase(LAS unsigned char* lds, const SchedT& S, const Epi& E, int wv) {
    int wvo = wv; asm volatile("" : "+s"(wvo));
    const int wid = wvo, wr = wid >> 2, wc = wid & 3;
#define PG8_TID() (TID_OF(wvo))
    const int tid = PG8_TID(); const int fr = tid & 15, fq = (tid >> 4) & 3;
    constexpr bool USE_BUF = true;
    const int K = S.K, nt = K / BK;
    unsigned vB[2], vA[2][2];
#pragma unroll
    for (int i = 0; i < 2; ++i) { int Rr, Cc; stage_rc(tid * 16 + i * 8192, Rr, Cc); const int Rb = Epi::PERM ? ((Rr & ~31) + perm32(Rr & 31)) : Rr;
        vB[i] = S.b_off(Rb, Cc); }
    const unsigned hA = (unsigned)S.a_hstep(), hB = (unsigned)S.b_hstep();
    const unsigned kstep = (unsigned)(BK * 2);
    const unsigned ldsw = (unsigned)wid * 1024u;
    const int aoff = lds_byte(wr * 64 + fr, fq * 8), boff = lds_byte(wc * 32 + fr, fq * 8);
#define PG8_SA(b, h) (((b) * 2 + (h)) * HTB)
#define PG8_SB(b, h) ((4 + (b) * 2 + (h)) * HTB)
#define PG8_STAGE(bufoff, rs, soff, voff) do { _Pragma("unroll") for (int _i = 0; _i < 2; ++_i) { \
        if constexpr (USE_BUF) __builtin_amdgcn_raw_ptr_buffer_load_lds(rs.r, (LAS void*)(lds + (bufoff) + ldsw + _i * 8192), 16, (voff)[_i], (soff), 0, 0); \
        else __builtin_amdgcn_global_load_lds((const unsigned*)(rs.p + (soff) + (voff)[_i]), (LAS unsigned*)(lds + (bufoff) + ldsw + _i * 8192), 16, 0, 0); } } while (0)
#define PG8_LDA(dst, b, h) do { if constexpr (Epi::FP8) { _Pragma("unroll") for (int m = 0; m < 4; ++m) { const i32x4 lo_ = *(const LAS i32x4*)(lds + PG8_SA(b, h) + aoff + m * 2048), hi_ = *(const LAS i32x4*)(lds + PG8_SA(b, h) + aoff + m * 2048 + 1024); \
            A8[m] = __builtin_shufflevector(lo_, hi_, 0, 1, 2, 3, 4, 5, 6, 7); } } \
        else { _Pragma("unroll") for (int m = 0; m < 4; ++m) _Pragma("unroll") for (int k = 0; k < 2; ++k) dst[m][k] = *(const LAS bf16x8*)(lds + PG8_SA(b, h) + aoff + m * 2048 + k * 1024); } } while (0)
#define PG8_LDB(dst, dst8, b, h) do { if constexpr (Epi::FP8) { _Pragma("unroll") for (int n = 0; n < 2; ++n) { const i32x4 lo_ = *(const LAS i32x4*)(lds + PG8_SB(b, h) + boff + n * 2048), hi_ = *(const LAS i32x4*)(lds + PG8_SB(b, h) + boff + n * 2048 + 1024); \
            dst8[n] = __builtin_shufflevector(lo_, hi_, 0, 1, 2, 3, 4, 5, 6, 7); } } \
        else { _Pragma("unroll") for (int n = 0; n < 2; ++n) _Pragma("unroll") for (int k = 0; k < 2; ++k) dst[n][k] = *(const LAS bf16x8*)(lds + PG8_SB(b, h) + boff + n * 2048 + k * 1024); } } while (0)
#define PG8_MMA(ai, bj, At, Bt, Bt8) do { __builtin_amdgcn_s_setprio(1); \
    if constexpr (Epi::FP8) { _Pragma("unroll") for (int m = 0; m < 4; ++m) _Pragma("unroll") for (int n = 0; n < 2; ++n) \
        acc[ai][bj][m][n] = __builtin_amdgcn_mfma_scale_f32_16x16x128_f8f6f4(Bt8[n], A8[m], acc[ai][bj][m][n], 0, 0, 0, 0x7F7F7F7F, 0, 0x7F7F7F7F); } \
    else { _Pragma("unroll") for (int m = 0; m < 4; ++m) _Pragma("unroll") for (int n = 0; n < 2; ++n) _Pragma("unroll") for (int k = 0; k < 2; ++k) \
        acc[ai][bj][m][n] = Epi::SWAP ? __builtin_amdgcn_mfma_f32_16x16x32_bf16(At[m][k], Bt[n][k], acc[ai][bj][m][n], 0, 0, 0) : __builtin_amdgcn_mfma_f32_16x16x32_bf16(Bt[n][k], At[m][k], acc[ai][bj][m][n], 0, 0, 0); } \
    __builtin_amdgcn_s_setprio(0); } while (0)
#define PG8_WAIT_V(n) asm volatile("s_waitcnt vmcnt(" #n ")" ::: "memory")
#define PG8_WAIT_L(n) asm volatile("s_waitcnt lgkmcnt(" #n ")" ::: "memory")
#define PG8_BAR __builtin_amdgcn_s_barrier()
#define PG8_SCHED __builtin_amdgcn_sched_barrier(0)
    Unit cur, nxt; int ui = 0;
    if (!S.next(0, cur)) return;
    f32x4 acc[2][2][4][2];
    { const float zi = zero_f_();
#pragma unroll
    for (int a = 0; a < 2; ++a)
#pragma unroll
        for (int b = 0; b < 2; ++b)
#pragma unroll
            for (int m = 0; m < 4; ++m)
#pragma unroll
                for (int n = 0; n < 2; ++n) acc[a][b][m][n] = (f32x4){zi, zi, zi, zi}; }
    bf16x8 At[4][2], B0[2][2], B1[2][2]; v8i32 A8[4], B80[2], B81[2];
    rsrc_t rA = mk_rsrc<USE_BUF>(S.a_base(cur)), rB = mk_rsrc<USE_BUF>(S.b_base(cur));
    S.a_offsets(cur, PG8_TID(), vA);
#define PG8_SLOT() (*(LAS u32x4*)(lds + L_SL2 + PG8_TID() * 16))
#define PG8_SLOTC() (*(LAS u32x4*)(lds + L_SS + PG8_TID() * 16))
    auto agofs = [&](int h, bool nx, unsigned (&o)[2]) { if constexpr (SchedT::GATHER) { const u32x2 t_ = *(const LAS u32x2*)(lds + (nx ? L_SL2 : L_SS) + PG8_TID() * 16 + h * 8); o[0] = t_.x; o[1] = t_.y; } else { o[0] = vA[h][0]; o[1] = vA[h][1]; } };
    if constexpr (SchedT::GATHER) PG8_SLOTC() = (u32x4){vA[0][0], vA[0][1], vA[1][0], vA[1][1]};
    if constexpr (SchedT::GATHER) { Unit n1; if (S.next(1, n1)) { unsigned vn[2][2]; S.a_offsets(n1, PG8_TID(), vn); PG8_SLOT() = (u32x4){vn[0][0], vn[0][1], vn[1][0], vn[1][1]}; } }
    PG8_STAGE(PG8_SB(0, 0), rB, 0u, vB); PG8_STAGE(PG8_SB(0, 1), rB, hB, vB); { unsigned o0[2], o1[2]; agofs(0, false, o0); agofs(1, false, o1); PG8_STAGE(PG8_SA(0, 0), rA, 0u, o0); PG8_STAGE(PG8_SA(0, 1), rA, hA, o1); }
    if (wr == 1) PG8_BAR;
    PG8_WAIT_V(2); PG8_BAR;
    PG8_STAGE(PG8_SB(1, 0), rB, kstep, vB); { unsigned o0[2]; agofs(0, false, o0); PG8_STAGE(PG8_SA(1, 0), rA, kstep, o0); } PG8_STAGE(PG8_SB(1, 1), rB, kstep + hB, vB);
    PG8_WAIT_V(6); PG8_BAR;
    for (;;) {
        const bool has_next = S.next(ui + 1, nxt);
        const rsrc_t rAn = has_next ? mk_rsrc<USE_BUF>(S.a_base(nxt)) : rA; const rsrc_t rBn = has_next ? mk_rsrc<USE_BUF>(S.b_base(nxt)) : rB;
#pragma unroll 1
        for (int t = 0; t < nt; t += 2) {
            const bool last = (t == nt - 2);
            const unsigned s1 = (unsigned)(t + 1) * kstep;
            const rsrc_t rA2 = last ? rAn : rA; const rsrc_t rB2 = last ? rBn : rB;
            const unsigned s2 = last ? 0u : (unsigned)(t + 2) * kstep; const unsigned s3 = s2 + kstep;
            const bool nx = last && has_next;
            if constexpr (Epi::HOOK) { if (t == Epi::H1 || t == Epi::H2) { const int t_h = PG8_TID(); E.mid(acc, cur, t, wr, wc, t_h & 15, (t_h >> 4) & 3); } }
            PG8_LDB(B0, B80, 0, 0); PG8_LDB(B1, B81, 0, 1); PG8_SCHED; PG8_LDA(At, 0, 0); { unsigned o_[2]; agofs(1, false, o_); PG8_STAGE(PG8_SA(1, 1), rA, s1 + hA, o_); }
            PG8_WAIT_V(8); PG8_WAIT_L(0); PG8_BAR; PG8_MMA(0, 0, At, B0, B80); PG8_MMA(0, 1, At, B1, B81); PG8_BAR; PG8_SCHED;
            PG8_LDA(At, 0, 1); PG8_STAGE(PG8_SB(0, 0), rB2, s2, vB); PG8_STAGE(PG8_SB(0, 1), rB2, s2 + hB, vB); { unsigned o_[2]; agofs(0, nx, o_); PG8_STAGE(PG8_SA(0, 0), rA2, s2, o_); }
            PG8_WAIT_V(8); PG8_WAIT_L(0); PG8_BAR; PG8_MMA(1, 0, At, B0, B80); PG8_MMA(1, 1, At, B1, B81); PG8_BAR; PG8_SCHED;
            PG8_LDB(B0, B80, 1, 0); PG8_LDB(B1, B81, 1, 1); PG8_SCHED; PG8_LDA(At, 1, 0); { unsigned o_[2]; agofs(1, nx, o_); PG8_STAGE(PG8_SA(0, 1), rA2, s2 + hA, o_); }
            PG8_WAIT_V(8); PG8_WAIT_L(0); PG8_BAR; PG8_MMA(0, 0, At, B0, B80); PG8_MMA(0, 1, At, B1, B81); PG8_BAR; PG8_SCHED;
            PG8_LDA(At, 1, 1); PG8_STAGE(PG8_SB(1, 0), rB2, s3, vB); PG8_STAGE(PG8_SB(1, 1), rB2, s3 + hB, vB); { unsigned o_[2]; agofs(0, nx, o_); PG8_STAGE(PG8_SA(1, 0), rA2, s3, o_); }
            PG8_WAIT_V(8); PG8_WAIT_L(0); PG8_BAR; PG8_MMA(1, 0, At, B0, B80); PG8_MMA(1, 1, At, B1, B81); PG8_BAR; PG8_SCHED;
        }
        unsigned vn2[2][2] = {{0u, 0u}, {0u, 0u}}; bool has_n2 = false;
        if constexpr (SchedT::GATHER) { Unit n2; has_n2 = has_next && S.next(ui + 2, n2); if (has_n2) S.a_offsets(n2, PG8_TID(), vn2); }
        if (wr == 0) PG8_BAR;
        { const int tid_e = PG8_TID();
          E(acc, cur, wr, wc, tid_e & 15, (tid_e >> 4) & 3, lds + RING_BYTES, tid_e); }
        if (!has_next) break;
        { const float z0 = zero_f_();
#pragma unroll
        for (int a = 0; a < 2; ++a)
#pragma unroll
            for (int b = 0; b < 2; ++b)
#pragma unroll
                for (int m = 0; m < 4; ++m)
#pragma unroll
                    for (int n = 0; n < 2; ++n) acc[a][b][m][n] = (f32x4){z0, z0, z0, z0}; }
        if constexpr (SchedT::MODE_ == 0) nxt.e = (nxt.pm == cur.pm) ? 1 : 0;
        cur = nxt; rA = rAn; rB = rBn; ++ui;
        if constexpr (SchedT::GATHER) { const u32x4 o = PG8_SLOT(); PG8_SLOTC() = o;
            if (has_n2) PG8_SLOT() = (u32x4){vn2[0][0], vn2[0][1], vn2[1][0], vn2[1][1]}; }
        if (wr == 1) PG8_BAR;
    }
    PG8_WAIT_V(0);
    PG8_BAR;
#undef PG8_SA
#undef PG8_SB
#undef PG8_STAGE
#undef PG8_LDA
#undef PG8_LDB
#undef PG8_MMA
#undef PG8_SLOT
#undef PG8_SLOTC
#undef PG8_TID
}
#define EPI_BAR() do { asm volatile("s_waitcnt lgkmcnt(0)" ::: "memory"); __builtin_amdgcn_s_barrier(); asm volatile("" ::: "memory"); } while (0)

template <int PERMTOK> __device__ __forceinline__ void finalize_rs(const float* xss, int base, LAS unsigned char* ext, int tid) {
    const int j = tid >> 1, hf = tid & 1; int tok;
    if (PERMTOK) { const int n = base + j; tok = 128 * (n & 127) + (n >> 7); } else tok = base + j;
    const f32x4* p = (const f32x4*)(xss + (size_t)tok * 32 + hf * 16); const f32x4 a = p[0], b = p[1], c = p[2], d = p[3];
    float s = ((a[0] + a[1]) + (a[2] + a[3])) + ((b[0] + b[1]) + (b[2] + b[3])) + ((c[0] + c[1]) + (c[2] + c[3])) + ((d[0] + d[1]) + (d[2] + d[3]));
    s += shflx(s, 1);
    if (hf == 0) ((LAS float*)(ext + (L_RS - RING_BYTES)))[j] = 1.f / sqrtf(s * (1.f / D) + EPS);
    EPI_BAR();
}
#define ACC_T const f32x4 (&acc)[2][2][4][2]

template <bool F8> struct EpInMain { static constexpr bool PERM = true, SWAP = false, HOOK = false, FP8 = F8; static constexpr int H1 = -1, H2 = -1;
    const float* xss; bf16 *qn, *kn, *qm; const float *qg, *kg, *mqg;
    __device__ __forceinline__ void operator()(ACC_T, const Unit& u, int wr, int wc, int fr, int fq, LAS unsigned char* ext, int tidx) const {
        if (!u.e) finalize_rs<0>(xss, u.pm * 256, ext, tidx);
        const LAS float* Trs = (const LAS float*)(ext + (L_RS - RING_BYTES)); LAS float* Tss = (LAS float*)(ext + (L_SS - RING_BYTES));
        const int pn = u.pn; const int lrow0 = wr * 64 + fr; const size_t grow0 = (size_t)u.pm * 256 + lrow0;
        bf16* dst; int ld, colt; const float* g; float sc;
        if (pn < 4) { dst = qn; ld = 1024; colt = pn * 256; g = qg; sc = QSCALE; } else if (pn < 8) { dst = kn; ld = 1024; colt = (pn - 4) * 256; g = kg; sc = 1.f; } else { dst = qm; ld = 512; colt = (pn - 8) * 256; g = mqg; sc = QSCALE; }
#pragma unroll
        for (int ai = 0; ai < 2; ++ai)
#pragma unroll
            for (int m = 0; m < 4; ++m) { const float rs = Trs[lrow0 + ai * 128 + m * 16] * (F8 ? (1.f / 64.f) : 1.f);
#pragma unroll
                for (int bj = 0; bj < 2; ++bj) { const f32x4 v0 = acc[ai][bj][m][0] * rs, v1 = acc[ai][bj][m][1] * rs;
                    float s = (v0[0] * v0[0] + v0[1] * v0[1]) + (v0[2] * v0[2] + v0[3] * v0[3]) + (v1[0] * v1[0] + v1[1] * v1[1]) + (v1[2] * v1[2] + v1[3] * v1[3]);
                    s += shflx(s, 16); s += shflx(s, 32);
                    if (fq == 0) Tss[((lrow0 + ai * 128 + m * 16) * 2 + bj) * 4 + wc] = s; } }
        EPI_BAR();
        const f32x4 g0 = *(const f32x4*)(g + wc * 32 + 8 * fq), g1 = *(const f32x4*)(g + wc * 32 + 8 * fq + 4);
#pragma unroll
        for (int ai = 0; ai < 2; ++ai)
#pragma unroll
            for (int m = 0; m < 4; ++m) { const float rs = Trs[lrow0 + ai * 128 + m * 16] * (F8 ? (1.f / 64.f) : 1.f); bf16* rowp = dst + (grow0 + ai * 128 + m * 16) * ld + colt + wc * 32 + 8 * fq;
#pragma unroll
                for (int bj = 0; bj < 2; ++bj) { const f32x4 ss4 = *(const LAS f32x4*)(Tss + ((lrow0 + ai * 128 + m * 16) * 2 + bj) * 4); const float tot = (ss4[0] + ss4[1]) + (ss4[2] + ss4[3]);
                    const float rn = rs * sc * __builtin_amdgcn_rsqf(tot * (1.f / HD) + EPS); const f32x4 v0 = acc[ai][bj][m][0] * rn * g0, v1 = acc[ai][bj][m][1] * rn * g1; u32x4 w;
                    w.x = cvt_pk_bf16(v0[0], v0[1]); w.y = cvt_pk_bf16(v0[2], v0[3]); w.z = cvt_pk_bf16(v1[0], v1[1]); w.w = cvt_pk_bf16(v1[2], v1[3]);
                    if (pn >= 4 && pn < 8) {
                        const int tok = (int)(grow0 + ai * 128 + m * 16); const int hd = 2 * (pn - 4) + bj, T = tok >> 5, rr = prow32(tok & 31), s_ = 2 * wc + (fq >> 1), h_ = fq & 1;
                        *(u32x4*)(kn + ((((size_t)(hd * 512 + T) * 8 + s_) * 64) + h_ * 32 + rr) * 8) = w; }
                    else *(u32x4*)(rowp + bj * 128) = w; }
                asm volatile("" ::: "memory"); }
    } };
struct EpGates8 { static constexpr bool PERM = true, SWAP = false, HOOK = false, FP8 = true; static constexpr int H1 = -1, H2 = -1;
    const float* xss; unsigned char* gt;
    static __device__ __forceinline__ unsigned q8(float z) { const float t = 255.f * sigmoidf_(z); return (unsigned)__builtin_rintf(__builtin_fmaxf(t, 1.f)); }
    static __device__ __forceinline__ unsigned q8s(float sg) { return (unsigned)__builtin_rintf(__builtin_fmaxf(255.f * sg, 1.f)); }
    static __device__ __forceinline__ unsigned q8x4(const f32x4 v) { const f32x4 sg = sigmoid4_(v); return q8s(sg[0]) | (q8s(sg[1]) << 8) | (q8s(sg[2]) << 16) | (q8s(sg[3]) << 24); }
    __device__ __forceinline__ void operator()(ACC_T, const Unit& u, int wr, int wc, int fr, int fq, LAS unsigned char* ext, int tidx) const {
        if (!u.e) finalize_rs<0>(xss, u.pm * 256, ext, tidx);
        const LAS float* Trs = (const LAS float*)(ext + (L_RS - RING_BYTES));
        const int lrow0 = wr * 64 + fr; const size_t grow0 = (size_t)u.pm * 256 + lrow0; const int col = u.pn * 256 + wc * 32 + 8 * fq;
#pragma unroll
        for (int ai = 0; ai < 2; ++ai)
#pragma unroll
            for (int m = 0; m < 4; ++m) { const float rs = Trs[lrow0 + ai * 128 + m * 16] * (1.f / 64.f); unsigned char* rowp = gt + (grow0 + ai * 128 + m * 16) * 6144 + col;
#pragma unroll
                for (int bj = 0; bj < 2; ++bj) { const f32x4 v0 = acc[ai][bj][m][0] * rs, v1 = acc[ai][bj][m][1] * rs; u32x2 w; w.x = q8x4(v0); w.y = q8x4(v1);
                    *(u32x2*)(rowp + bj * 128) = w; }
                asm volatile("" ::: "memory"); }
    } };
template <int PERMTOK, bool F8 = false> struct EpT { static constexpr bool PERM = true, SWAP = false, HOOK = false, FP8 = F8; static constexpr int H1 = -1, H2 = -1;
    const float* xss; bf16* dst;
    __device__ __forceinline__ void operator()(ACC_T, const Unit& u, int wr, int wc, int fr, int fq, LAS unsigned char* ext, int tidx) const {
        finalize_rs<PERMTOK>(xss, u.pn * 256, ext, tidx);
        const LAS float* Trs = (const LAS float*)(ext + (L_RS - RING_BYTES));
        f32x4 r0[2], r1[2];
#pragma unroll
        for (int bj = 0; bj < 2; ++bj) { r0[bj] = *(const LAS f32x4*)(Trs + bj * 128 + wc * 32 + 8 * fq); r1[bj] = *(const LAS f32x4*)(Trs + bj * 128 + wc * 32 + 8 * fq + 4); if (F8) { r0[bj] = r0[bj] * (1.f / 64.f); r1[bj] = r1[bj] * (1.f / 64.f); } }
        const size_t grow0 = (size_t)u.pm * 256 + wr * 64 + fr; const int col = u.pn * 256 + wc * 32 + 8 * fq;
#pragma unroll
        for (int ai = 0; ai < 2; ++ai)
#pragma unroll
            for (int m = 0; m < 4; ++m) { bf16* rowp = dst + (grow0 + ai * 128 + m * 16) * S + col;
#pragma unroll
                for (int bj = 0; bj < 2; ++bj) { const f32x4 v0 = acc[ai][bj][m][0] * r0[bj], v1 = acc[ai][bj][m][1] * r1[bj]; u32x4 w;
                    w.x = cvt_pk_bf16(v0[0], v0[1]); w.y = cvt_pk_bf16(v0[2], v0[3]); w.z = cvt_pk_bf16(v1[0], v1[1]); w.w = cvt_pk_bf16(v1[2], v1[3]);
                    if (PERMTOK == 0) {
                        const int f = (int)(grow0 + ai * 128 + m * 16); const int hd = f >> 7, dd = f & 127, T = 8 * u.pn + 4 * bj + wc;
                        *(u32x4*)(dst + (((((size_t)(hd * 512 + T) * 4 + (dd >> 5)) * 2 + (fq >> 1)) * 64) + (fq & 1) * 32 + (dd & 31)) * 8) = w; }
                    else *(u32x4*)(rowp + bj * 128) = w; } }
    } };
__device__ __forceinline__ f32x4 bf4_to_f32(u32x2 g) { return (f32x4){bf2f(g.x & 0xffff), bf2f(g.x >> 16), bf2f(g.y & 0xffff), bf2f(g.y >> 16)}; }
template <bool MG8> struct EpMerge { static constexpr bool PERM = true, SWAP = false, HOOK = true, FP8 = false; static constexpr int H1 = 16, H2 = 24;
    const unsigned char* gt; bf16* mg;
    static __device__ __forceinline__ f32x4 ub4(unsigned w) { return (f32x4){(float)(w & 0xffu), (float)((w >> 8) & 0xffu), (float)((w >> 16) & 0xffu), (float)(w >> 24)}; }
    __device__ __forceinline__ void mid(f32x4 (&acc)[2][2][4][2], const Unit& u, int t, int wr, int wc, int fr, int fq) const {
        const int gnum = (t == H1) ? 2048 : 4096, gden = (t == H1) ? 4096 : 0;
        const size_t grow0 = (size_t)u.pm * 256 + wr * 64 + fr; const int col0 = u.pn * 256 + wc * 32 + 8 * fq;
#pragma unroll
        for (int ai = 0; ai < 2; ++ai) {
            u32x2 av[4][2], dv[4][2];
#pragma unroll
            for (int m = 0; m < 4; ++m) { const unsigned char* gp = gt + (grow0 + ai * 128 + m * 16) * 6144 + col0;
#pragma unroll
                for (int bj = 0; bj < 2; ++bj) { av[m][bj] = *(const u32x2*)(gp + gnum + bj * 128); dv[m][bj] = *(const u32x2*)(gp + gden + bj * 128); } }
            asm volatile("" : "+v"(av[0][0]), "+v"(av[0][1]), "+v"(av[1][0]), "+v"(av[1][1]), "+v"(av[2][0]), "+v"(av[2][1]), "+v"(av[3][0]), "+v"(av[3][1]),
                              "+v"(dv[0][0]), "+v"(dv[0][1]), "+v"(dv[1][0]), "+v"(dv[1][1]), "+v"(dv[2][0]), "+v"(dv[2][1]), "+v"(dv[3][0]), "+v"(dv[3][1]));
#pragma unroll
            for (int m = 0; m < 4; ++m) {
#pragma unroll
                for (int bj = 0; bj < 2; ++bj) { const u32x2 a = av[m][bj], d = dv[m][bj];
                    const f32x4 a0 = ub4(a.x), a1 = ub4(a.y), d0 = ub4(d.x), d1 = ub4(d.y);
#pragma unroll
                    for (int q = 0; q < 4; ++q) { acc[ai][bj][m][0][q] *= a0[q] * __builtin_amdgcn_rcpf(d0[q]); acc[ai][bj][m][1][q] *= a1[q] * __builtin_amdgcn_rcpf(d1[q]); } } }
            asm volatile("" ::: "memory"); }
    }
    __device__ __forceinline__ void operator()(ACC_T, const Unit& u, int wr, int wc, int fr, int fq, LAS unsigned char*, int) const {
        const size_t grow0 = (size_t)u.pm * 256 + wr * 64 + fr; const int col0 = u.pn * 256 + wc * 32 + 8 * fq;
#pragma unroll
        for (int ai = 0; ai < 2; ++ai) {
            u32x2 gv[4][2];
#pragma unroll
            for (int m = 0; m < 4; ++m)
#pragma unroll
                for (int bj = 0; bj < 2; ++bj) gv[m][bj] = *(const u32x2*)(gt + (grow0 + ai * 128 + m * 16) * 6144 + col0 + bj * 128);
            asm volatile("" : "+v"(gv[0][0]), "+v"(gv[0][1]), "+v"(gv[1][0]), "+v"(gv[1][1]), "+v"(gv[2][0]), "+v"(gv[2][1]), "+v"(gv[3][0]), "+v"(gv[3][1]));
#pragma unroll
            for (int m = 0; m < 4; ++m) { const size_t row = grow0 + ai * 128 + m * 16;
#pragma unroll
                for (int bj = 0; bj < 2; ++bj) { const int c = col0 + bj * 128; const u32x2 g = gv[m][bj];
                    const f32x4 o0 = ub4(g.x) * acc[ai][bj][m][0] * ((MG8 ? 16.f : 1.f) / 255.f), o1 = ub4(g.y) * acc[ai][bj][m][1] * ((MG8 ? 16.f : 1.f) / 255.f);
                    if (MG8) { int w0 = zero_i_(), w1 = zero_i_(); w0 = __builtin_amdgcn_cvt_pk_fp8_f32(o0[0], o0[1], w0, false); w0 = __builtin_amdgcn_cvt_pk_fp8_f32(o0[2], o0[3], w0, true);
                        w1 = __builtin_amdgcn_cvt_pk_fp8_f32(o1[0], o1[1], w1, false); w1 = __builtin_amdgcn_cvt_pk_fp8_f32(o1[2], o1[3], w1, true);
                        u32x2 w; w.x = (unsigned)w0; w.y = (unsigned)w1; *(u32x2*)((unsigned char*)mg + row * D + c) = w; }
                    else { u32x4 w; w.x = cvt_pk_bf16(o0[0], o0[1]); w.y = cvt_pk_bf16(o0[2], o0[3]); w.z = cvt_pk_bf16(o1[0], o1[1]); w.w = cvt_pk_bf16(o1[2], o1[3]);
                        *(u32x4*)(mg + row * D + c) = w; } } }
            asm volatile("" ::: "memory"); }
    } };
template <int XB8, int SCI = 1> struct EpRes { static constexpr bool PERM = true, SWAP = false, HOOK = false, FP8 = (SCI != 1); static constexpr int H1 = -1, H2 = -1; static constexpr float SC = 1.f / (float)SCI;
    bf16* xb; float* xss; unsigned char* xb8;
    __device__ __forceinline__ void operator()(ACC_T, const Unit& u, int wr, int wc, int fr, int fq, LAS unsigned char*, int) const {
        const size_t grow0 = (size_t)u.pm * 256 + wr * 64 + fr; const int col0 = u.pn * 256 + wc * 32 + 8 * fq;
#pragma unroll
        for (int ai = 0; ai < 2; ++ai) {
            u32x4 oldv[4][2];
#pragma unroll
            for (int m = 0; m < 4; ++m)
#pragma unroll
                for (int bj = 0; bj < 2; ++bj) oldv[m][bj] = *(const u32x4*)(xb + (grow0 + ai * 128 + m * 16) * D + col0 + bj * 128);
            asm volatile("" : "+v"(oldv[0][0]), "+v"(oldv[0][1]), "+v"(oldv[1][0]), "+v"(oldv[1][1]), "+v"(oldv[2][0]), "+v"(oldv[2][1]), "+v"(oldv[3][0]), "+v"(oldv[3][1]));
#pragma unroll
            for (int m = 0; m < 4; ++m) { const size_t row = grow0 + ai * 128 + m * 16; float ss = 0.f;
#pragma unroll
                for (int bj = 0; bj < 2; ++bj) { const int c = col0 + bj * 128; const u32x4 old = oldv[m][bj];
                    const f32x4 o0 = bf4_to_f32((u32x2){old.x, old.y}) + acc[ai][bj][m][0] * SC, o1 = bf4_to_f32((u32x2){old.z, old.w}) + acc[ai][bj][m][1] * SC; u32x4 w;
                    w.x = cvt_pk_bf16(o0[0], o0[1]); w.y = cvt_pk_bf16(o0[2], o0[3]); w.z = cvt_pk_bf16(o1[0], o1[1]); w.w = cvt_pk_bf16(o1[2], o1[3]); *(u32x4*)(xb + row * D + c) = w;
                    if (XB8 != 0) { int w0 = zero_i_(), w1 = zero_i_(); w0 = __builtin_amdgcn_cvt_pk_fp8_f32(o0[0], o0[1], w0, false); w0 = __builtin_amdgcn_cvt_pk_fp8_f32(o0[2], o0[3], w0, true);
                        w1 = __builtin_amdgcn_cvt_pk_fp8_f32(o1[0], o1[1], w1, false); w1 = __builtin_amdgcn_cvt_pk_fp8_f32(o1[2], o1[3], w1, true); u32x2 w8; w8.x = (unsigned)w0; w8.y = (unsigned)w1; *(u32x2*)(xb8 + row * D + c) = w8; }
                    ss += ((o0[0] * o0[0] + o0[1] * o0[1]) + (o0[2] * o0[2] + o0[3] * o0[3])) + ((o1[0] * o1[0] + o1[1] * o1[1]) + (o1[2] * o1[2] + o1[3] * o1[3])); }
                if (xss) { ss += shflx(ss, 16); ss += shflx(ss, 32); if (fq == 0) xss[row * 32 + u.pn * 4 + wc] = ss; } } }
    } };
template <int MOE> struct EpGU { static constexpr bool PERM = true, SWAP = false, HOOK = false, FP8 = false; static constexpr int H1 = -1, H2 = -1;
    const float* xss; const float* rstok; const int* tokl; bf16* hm; const LAS int* mt;
    __device__ __forceinline__ void operator()(ACC_T, const Unit& u, int wr, int wc, int fr, int fq, LAS unsigned char* ext, int tidx) const {
        const int lrow0 = wr * 64 + fr; const int col = u.pn * 128 + wc * 16 + 4 * fq;
        const LAS float* Trs = (const LAS float*)(ext + (L_RS - RING_BYTES));
        if (!MOE && !u.e) finalize_rs<0>(xss, u.pm * 256, ext, tidx);
        const int e = u.e & 255, j = u.e >> 8; const int cn = MOE ? mt[e] : 0;
#pragma unroll
        for (int ai = 0; ai < 2; ++ai)
#pragma unroll
            for (int m = 0; m < 4; ++m) { const int lr = lrow0 + ai * 128 + m * 16; float rs;
                if (MOE) { int slot = 256 * j + lr; if (slot >= cn) slot = 0; rs = rstok[tokl[e * CAP + slot]]; } else rs = Trs[lr];
                bf16* rowp = hm + ((size_t)u.pm * 256 + lr) * DFF + col;
#pragma unroll
                for (int bj = 0; bj < 2; ++bj) { const f32x4 gq = acc[ai][bj][m][0] * rs, uq = acc[ai][bj][m][1] * rs; const f32x4 sg = sigmoid4_(gq); f32x4 o;
#pragma unroll
                    for (int q = 0; q < 4; ++q) o[q] = gq[q] * sg[q] * uq[q];
                    u32x2 w; w.x = cvt_pk_bf16(o[0], o[1]); w.y = cvt_pk_bf16(o[2], o[3]); *(u32x2*)(rowp + bj * 64) = w; }
                asm volatile("" ::: "memory"); }
    } };
struct EpGU8 { static constexpr bool PERM = true, SWAP = false, HOOK = false, FP8 = true; static constexpr int H1 = -1, H2 = -1;
    const float* rstok; const int* tokl; unsigned char* hm; const LAS int* mt;
    __device__ __forceinline__ void operator()(ACC_T, const Unit& u, int wr, int wc, int fr, int fq, LAS unsigned char*, int) const {
        const int lrow0 = wr * 64 + fr; const int col = u.pn * 128 + wc * 16 + 4 * fq; const int e = u.e & 255, j = u.e >> 8; const int cn = mt[e];
        float rsv[2][4];
#pragma unroll
        for (int ai = 0; ai < 2; ++ai)
#pragma unroll
            for (int m = 0; m < 4; ++m) { int slot = 256 * j + lrow0 + ai * 128 + m * 16; if (slot >= cn) slot = 0; rsv[ai][m] = rstok[e * CAP + slot]; }
        asm volatile("" : "+v"(rsv[0][0]), "+v"(rsv[0][1]), "+v"(rsv[0][2]), "+v"(rsv[0][3]), "+v"(rsv[1][0]), "+v"(rsv[1][1]), "+v"(rsv[1][2]), "+v"(rsv[1][3]));
#pragma unroll
        for (int ai = 0; ai < 2; ++ai)
#pragma unroll
            for (int m = 0; m < 4; ++m) { const int lr = lrow0 + ai * 128 + m * 16; const float rs = rsv[ai][m] * (1.f / 64.f);
                unsigned char* rowp = hm + ((size_t)u.pm * 256 + lr) * DFF + col;
#pragma unroll
                for (int bj = 0; bj < 2; ++bj) { const f32x4 gq = acc[ai][bj][m][0] * rs, uq = acc[ai][bj][m][1] * rs; const f32x4 sg = sigmoid4_(gq); f32x4 o;
#pragma unroll
                    for (int q = 0; q < 4; ++q) o[q] = 4.f * gq[q] * sg[q] * uq[q];
                    int w8 = zero_i_(); w8 = __builtin_amdgcn_cvt_pk_fp8_f32(o[0], o[1], w8, false); w8 = __builtin_amdgcn_cvt_pk_fp8_f32(o[2], o[3], w8, true); *(int*)(rowp + bj * 64) = w8; }
                asm volatile("" ::: "memory"); }
    } };
struct EpMoeY { static constexpr bool PERM = true, SWAP = false, HOOK = false, FP8 = true; static constexpr int H1 = -1, H2 = -1;
    bf16* yb;
    __device__ __forceinline__ void operator()(ACC_T, const Unit& u, int wr, int wc, int fr, int fq, LAS unsigned char*, int) const {
        const size_t grow0 = (size_t)u.pm * 256 + wr * 64 + fr; const int col0 = u.pn * 256 + wc * 32 + 8 * fq; const float sc = 1.f / 256.f;
#pragma unroll
        for (int ai = 0; ai < 2; ++ai)
#pragma unroll
            for (int m = 0; m < 4; ++m) { bf16* rowp = yb + (grow0 + ai * 128 + m * 16) * D + col0;
#pragma unroll
                for (int bj = 0; bj < 2; ++bj) { const f32x4 v0 = acc[ai][bj][m][0] * sc, v1 = acc[ai][bj][m][1] * sc; u32x4 w;
                    w.x = cvt_pk_bf16(v0[0], v0[1]); w.y = cvt_pk_bf16(v0[2], v0[3]); w.z = cvt_pk_bf16(v1[0], v1[1]); w.w = cvt_pk_bf16(v1[2], v1[3]);
                    *(u32x4*)(rowp + bj * 128) = w; } }
    } };
}

#define XB_TMO      128
#define XB_XCNT(j)  (256  + 64 * (j))
#define XB_XSUB(j)  (1280 + 64 * (j))
#define XB_XGEN(j)  (2304 + 64 * (j))
#define XB_TOP      3328
#define XB_TOPGEN   3392
#define XCD_BAR_WORDS 3456
#define XB_SPIN_CAP (1u << 18)
__device__ __forceinline__ unsigned xb_ld(unsigned* p)              { return __hip_atomic_load((GAS unsigned*)p, __ATOMIC_RELAXED, __HIP_MEMORY_SCOPE_AGENT); }
__device__ __forceinline__ unsigned xb_add(unsigned* p, unsigned v) { return __hip_atomic_fetch_add((GAS unsigned*)p, v, __ATOMIC_RELAXED, __HIP_MEMORY_SCOPE_AGENT); }
__device__ __forceinline__ unsigned xb_xcc_id() { return (unsigned)__builtin_amdgcn_s_getreg((3 << 11) | 20) & 0xFu; }
#define XB_SPIN(cond, bar) do { unsigned _sp = 0; while (cond) { __builtin_amdgcn_s_sleep(1); \
    if ((++_sp & 255u) == 0u) { if (xb_ld(&(bar)[XB_TMO])) break; if (_sp > XB_SPIN_CAP) { (void)xb_add(&(bar)[XB_TMO], 1u); break; } } } } while (0)
struct XcdBarrier { unsigned* bar; unsigned x; volatile LAS unsigned* st; int wv; };
__device__ __forceinline__ XcdBarrier xcd_barrier_post(unsigned* bar, volatile LAS unsigned* st, int wv) {
    XcdBarrier b; b.bar = bar; b.x = xb_xcc_id(); b.st = st; b.wv = wv;
    if (threadIdx.x == 0) (void)xb_add(&bar[XB_XCNT(b.x)], 1u);
    return b;
}
__device__ __forceinline__ void xcd_barrier_complete(unsigned* bar, unsigned x, unsigned& nloc, unsigned& nx) {
    const unsigned G = gridDim.x * gridDim.y * gridDim.z;
    unsigned sum, cnt, mine, sp = 0u;
    for (;;) {
        sum = 0u; cnt = 0u; mine = 0u;
#pragma unroll
        for (unsigned j = 0; j < 16; ++j) { const unsigned c = xb_ld(&bar[XB_XCNT(j)]); sum += c; cnt += (c > 0u) ? 1u : 0u; mine = (j == x) ? c : mine; }
        if (sum == G) break;
        __builtin_amdgcn_s_sleep(1);
        if ((++sp & 255u) == 0u) { if (xb_ld(&bar[XB_TMO])) break; if (sp > XB_SPIN_CAP) { (void)xb_add(&bar[XB_TMO], 1u); break; } }
    }
    nloc = mine > 0u ? mine : 1u; nx = cnt > 0u ? cnt : 1u;
}
__device__ __forceinline__ void xcd_barrier(const XcdBarrier& b) {
    asm volatile("s_waitcnt vmcnt(0)" ::: "memory");
    __syncthreads();
    if (b.wv == 0 && lane_id_() == 0) {
        unsigned* bar = b.bar; asm volatile("" : "+v"(bar));
        __builtin_amdgcn_s_waitcnt(0);
        unsigned nloc = b.st[0], nx = b.st[1];
        if (nloc == 0u) { xcd_barrier_complete(bar, b.x, nloc, nx); b.st[0] = nloc; b.st[1] = nx; }
        const unsigned old = xb_add(&bar[XB_XSUB(b.x)], 1u);
        const unsigned gen = old / nloc;
        if (old + 1u == (gen + 1u) * nloc) {
            __builtin_amdgcn_fence(__ATOMIC_RELEASE, "agent");
            asm volatile("s_waitcnt vmcnt(0)" ::: "memory");
            const unsigned og = xb_add(&bar[XB_TOP], 1u);
            const unsigned tg = og / nx;
            if (og + 1u == (tg + 1u) * nx) xb_add(&bar[XB_TOPGEN], 1u);
            else XB_SPIN(xb_ld(&bar[XB_TOPGEN]) == tg, bar);
            __builtin_amdgcn_fence(__ATOMIC_ACQUIRE, "agent");
            xb_add(&bar[XB_XGEN(b.x)], 1u);
            asm volatile("s_waitcnt vmcnt(0)" ::: "memory");
        } else {
            XB_SPIN(xb_ld(&bar[XB_XGEN(b.x)]) == gen, bar);
            __builtin_amdgcn_fence(__ATOMIC_ACQUIRE, "agent");
            asm volatile("s_waitcnt vmcnt(0)" ::: "memory");
        }
    }
    __syncthreads();
}

constexpr int CW_F1 = 128;
constexpr int CW_BAR = 4096;
struct MArgs { const void* ptr[25]; int ph_lo, ph_hi, li, pad; };
__device__ __forceinline__ const void* arg_ptr(const MArgs& a, int k) { asm volatile("" : "+s"(k)); return a.ptr[k]; }
#define AIN(k) ((const float*)(const GAS float*)arg_ptr(a, (k)))
#define AOUT ((float*)(GAS float*)arg_ptr(a, 23))
#define AWS ((unsigned char*)(GAS unsigned char*)arg_ptr(a, 24))
constexpr int NPHASE = 18;

__device__ __forceinline__ void moe_tables(LAS int* mt, const unsigned* cnt, int t) {
    if (t < 160) { int ts = 0, mye = 0;
#pragma unroll
        for (int e = 0; e < NE; ++e) { const int c = (int)cnt[e]; if (t == e) { mt[e] = c; mt[9 + e] = ts; } if (e > 0 && ts <= t) mye = e; ts += (c + 255) >> 8; }
        mt[32 + t] = mye; if (t == 8) mt[8] = ts; }
    asm volatile("s_waitcnt lgkmcnt(0)" ::: "memory"); __syncthreads();
}

__global__ void __launch_bounds__(512, 2) mega(MArgs a) {
    extern __shared__ __attribute__((aligned(16))) unsigned char lds_raw[];
    LAS unsigned char* lds = (LAS unsigned char*)lds_raw;
    const int wave_s = __builtin_amdgcn_readfirstlane(threadIdx.x >> 6);
    unsigned char* ws = AWS;
    volatile LAS unsigned* MISC = (volatile LAS unsigned*)(lds + L_MISC);
    for (int u = threadIdx.x; u < (LDS_BYTES - RING_BYTES) / 4; u += 512) ((LAS unsigned*)(lds + RING_BYTES))[u] = 0u;
    __syncthreads();
    XcdBarrier bar = xcd_barrier_post((unsigned*)(ws + OFF_CTL) + CW_BAR + a.li * XCD_BAR_WORDS, MISC + 8, wave_s);
    const int lo = a.ph_lo, hi = a.ph_hi;
#define IN(k) (lo <= (k) && (k) < hi)
#define SEAM(k) do { if (IN(k) && IN((k) + 1)) xcd_barrier(bar); } while (0)
    LAS int* mt = (LAS int*)(lds + L_MOE);

#define PHASE_BEGIN() int tid = TID_OF(wave_s); asm volatile("" : "+v"(tid)); const int lane = tid & 63; (void)lane; \
    int G = gridDim.x, bx = blockIdx.x; asm volatile("" : "+s"(G), "+s"(bx)); const int wave = wave_s; \
    const int vcu = (G % 8 == 0) ? (bx % 8) * (G / 8) + bx / 8 : bx; const int gw = vcu * 8 + wave, NGW = G * 8; (void)gw; (void)NGW; (void)vcu; \
    unsigned char* ws = AWS; unsigned* ctl = (unsigned*)(ws + OFF_CTL); (void)ctl; \
    bf16 *xb = (bf16*)(ws + OFF_XB), *qn = (bf16*)(ws + OFF_QN), *kn = (bf16*)(ws + OFF_KN), *vT = (bf16*)(ws + OFF_VT), *qm = (bf16*)(ws + OFF_QM), *gt = (bf16*)(ws + OFF_GT), *finT = (bf16*)(ws + OFF_FINT); \
    bf16 *ym = (bf16*)(ws + OFF_YM), *ona = (bf16*)(ws + OFF_ONA), *omem = (bf16*)(ws + OFF_OMEM), *mg = (bf16*)(ws + OFF_MG), *hm = (bf16*)(ws + OFF_HMID); \
    bf16* actm = (bf16*)(ws + OFF_ACTM); (void)actm; float* mpart = (float*)(ws + OFF_MPART); float* xssA = (float*)(ws + OFF_XSS); float* xssB = (float*)(ws + OFF_XSS2); \
    (void)xb; (void)qn; (void)kn; (void)vT; (void)qm; (void)gt; (void)finT; (void)ym; (void)ona; (void)omem; (void)mg; (void)hm; (void)mpart; (void)xssA; (void)xssB
    if (IN(0)) { PHASE_BEGIN();
        const bool helpers_first = (bx & 1) != 0;
        auto run_helpers = [&]() {
        { const int tid = TID_OF(wave_s); bf16* dC = (bf16*)(ws + OFF_DFTC); bf16* dS = (bf16*)(ws + OFF_DFTS); float* tw = (float*)(ws + OFF_TW); const int gt_ = vcu * 512 + tid, GT = G * 512; const float isq = 0.08838834764831845f;
          for (int i = gt_; i < 128 * 128; i += GT) { const int aa = i >> 7, bb = i & 127; const int m = (aa * bb) & 127; const float ang = (float)m * (2.0f / 128.0f); dC[i] = (bf16)f2bf(cospif(ang) * isq); dS[i] = (bf16)f2bf(sinpif(ang) * isq); }
          for (int i = gt_; i < 16384; i += GT) { const float ang = (float)i * (2.0f / 16384.0f); tw[2 * i] = cospif(ang); tw[2 * i + 1] = sinpif(ang); }
          { float* rp = (float*)(ws + OFF_RPBP); const float* rpb_in = AIN(6);
            for (int i = gt_; i < 2 * 8 * 15 * 128; i += GT) { const int j = (i & 127) - 48, row = i >> 7; rp[i] = (j >= 0 && j < 31) ? rpb_in[row * 31 + j] * 1.4426950408889634f : 0.f; } } }
        { const int lane = TID_OF(wave_s) & 63;
        for (int m = gw; m < S; m += NGW) { const f32x4* xr = (const f32x4*)(AIN(0) + (size_t)m * D) + lane; float s = 0.f; u32x2* o = (u32x2*)(xb + (size_t)m * D) + lane;
#pragma unroll
            for (int j = 0; j < 8; ++j) { const f32x4 v = xr[64 * j]; s += (v.x * v.x + v.y * v.y) + (v.z * v.z + v.w * v.w); u32x2 w; w.x = pk2(v.x, v.y); w.y = pk2(v.z, v.w); o[64 * j] = w;
                int w8 = zero_i_(); w8 = __builtin_amdgcn_cvt_pk_fp8_f32(v.x, v.y, w8, false); w8 = __builtin_amdgcn_cvt_pk_fp8_f32(v.z, v.w, w8, true); ((int*)(ws + OFF_XB8 + (size_t)m * D))[lane + 64 * j] = w8; }
            s = wave_sum(s); if (lane < 32) xssA[(size_t)m * 32 + lane] = lane == 0 ? s : 0.f; } }
        { const int tid = TID_OF(wave_s); float* cs = (float*)(lds_raw); if (tid < 128) { const float ang = (float)tid * (2.0f / 128.0f); cs[tid] = cospif(ang); cs[128 + tid] = sinpif(ang); } __syncthreads();
          const float isq = 0.08838834764831845f;
          int tw_ = tid; asm volatile("" : "+v"(tw_));
          for (int it = vcu * 512 + tw_; it < 2 * 128 * 512; it += G * 512) {
              const int n4 = it & 511, k8 = (it >> 9) & 127, l = it >> 16; const int kk0 = k8 * 8, im = kk0 >= 512, g = (kk0 & 511) >> 7, c0 = kk0 & 127;
              const float* Wf = AIN(11) + (size_t)l * 512 * D + (size_t)(g * 128) * D + 4 * n4; const float* tb = cs + (im ? 128 : 0); const float sg = im ? -isq : isq;
              f32x4 acc8[8];
#pragma unroll
              for (int j = 0; j < 8; ++j) acc8[j] = (f32x4){0.f, 0.f, 0.f, 0.f};
              int mi[8];
#pragma unroll
              for (int j = 0; j < 8; ++j) mi[j] = 0;
              for (int cp0 = 0; cp0 < 128; cp0 += 16) { f32x4 w[16];
#pragma unroll
                  for (int q = 0; q < 16; ++q) w[q] = *(const f32x4*)(Wf + (size_t)(cp0 + q) * D);
#pragma unroll
                  for (int q = 0; q < 16; ++q)
#pragma unroll
                      for (int j = 0; j < 8; ++j) { acc8[j] += w[q] * tb[mi[j]]; mi[j] = (mi[j] + c0 + j) & 127; } }
              bf16* dstp = (bf16*)(ws + OFF_WALL + l * SZ_WALL) + (size_t)(4 * n4) * LDM + 1536 + kk0;
#pragma unroll
              for (int q = 0; q < 4; ++q) { u32x4 o; o.x = pk2(acc8[0][q] * sg, acc8[1][q] * sg); o.y = pk2(acc8[2][q] * sg, acc8[3][q] * sg); o.z = pk2(acc8[4][q] * sg, acc8[5][q] * sg); o.w = pk2(acc8[6][q] * sg, acc8[7][q] * sg);
                  *(u32x4*)(dstp + (size_t)q * LDM) = o; } }
          __syncthreads(); }
        for (int b = vcu; b < 256; b += G) { float* sm = (float*)lds_raw;
            float* red = sm + 512 * 16; float* srs = red + 8 * 16 * 128; float* sred = srs + 16;
            int t = TID_OF(wave_s); asm volatile("" : "+v"(t));
            const int l = b >> 7, ch = (b >> 4) & 7, rg = b & 15; const int cq = t & 31, kg = (t >> 5) & 7, rq = t >> 8; const int lane = t & 63;
            const float* mem = AIN(1) + (size_t)(rg * 16) * D; const float* g = AIN(7) + l * D; const float* W = AIN(8) + (size_t)l * D * 1024 + ch * 128 + 4 * cq;
            __syncthreads();
            for (int r = wave * 2; r < wave * 2 + 2; ++r) { float s = 0.f; for (int k = lane; k < D; k += 64) { const float v = mem[(size_t)r * D + k]; s += v * v; } s = wave_sum(s); if (lane == 0) srs[r] = 1.f / sqrtf(s * (1.f / D) + EPS); }
            f32x4 acc4[8];
#pragma unroll
            for (int j = 0; j < 8; ++j) acc4[j] = (f32x4){0.f, 0.f, 0.f, 0.f};
            for (int kc = 0; kc < D; kc += 512) {
                __syncthreads();
                for (int i = t; i < 16 * 512; i += 512) { const int r = i >> 9, k = i & 511; sm[k * 16 + r] = mem[(size_t)r * D + kc + k] * g[kc + k]; }
                __syncthreads();
                for (int k = kg * 64; k < kg * 64 + 64; k += 8) { f32x4 w[8];
#pragma unroll
                    for (int q = 0; q < 8; ++q) w[q] = *(const f32x4*)(W + (size_t)(kc + k + q) * 1024);
#pragma unroll
                    for (int q = 0; q < 8; ++q) { const f32x4 m0 = *(const f32x4*)(sm + (k + q) * 16 + 8 * rq), m1 = *(const f32x4*)(sm + (k + q) * 16 + 8 * rq + 4);
#pragma unroll
                        for (int j = 0; j < 4; ++j) { acc4[j] += w[q] * m0[j]; acc4[4 + j] += w[q] * m1[j]; } } } }
            __syncthreads();
#pragma unroll
            for (int j = 0; j < 8; ++j) *(f32x4*)(red + ((kg * 16 + rq * 8 + j) * 128) + 4 * cq) = acc4[j];
            __syncthreads();
            { const int col = t & 127, rq2 = t >> 7; float acc[4];
#pragma unroll
              for (int j = 0; j < 4; ++j) { const int r = rq2 * 4 + j; acc[j] = (((red[(0 * 16 + r) * 128 + col] + red[(1 * 16 + r) * 128 + col]) + (red[(2 * 16 + r) * 128 + col] + red[(3 * 16 + r) * 128 + col])) + ((red[(4 * 16 + r) * 128 + col] + red[(5 * 16 + r) * 128 + col]) + (red[(6 * 16 + r) * 128 + col] + red[(7 * 16 + r) * 128 + col]))) * srs[r]; }
              if (ch < 4) {
#pragma unroll
                  for (int j = 0; j < 4; ++j) { float s = wave_sum(acc[j] * acc[j]); if (lane == 0) sred[(rq2 * 4 + j) * 2 + (wave & 1)] = s; }
                  __syncthreads();
                  const float kg_ = AIN(10)[l * HD + col]; bf16* dst = (bf16*)(ws + OFF_KMEM) + ((size_t)(l * 4 + ch) * NMEM) * HD;
#pragma unroll
                  for (int j = 0; j < 4; ++j) { const int r = rq2 * 4 + j; const float ss = sred[r * 2] + sred[r * 2 + 1]; const float rn = 1.f / sqrtf(ss * (1.f / HD) + EPS); const int mrow = rg * 16 + r;
                      dst[((((size_t)(mrow >> 5) * 8 + (col >> 4)) * 64) + ((col >> 3) & 1) * 32 + prow32(mrow & 31)) * 8 + (col & 7)] = (bf16)f2bf(acc[j] * rn * kg_); }
              } else { bf16* dst = (bf16*)(ws + OFF_VMEMT) + ((size_t)(l * 4 + (ch - 4)) * HD) * NMEM;
#pragma unroll
                  for (int j = 0; j < 4; ++j) { const int mrow = rg * 16 + rq2 * 4 + j, o_ = mrow & 31; dst[(((((size_t)(mrow >> 5) * 4 + (col >> 5)) * 2 + (o_ >> 4)) * 64) + ((o_ >> 3) & 1) * 32 + (col & 31)) * 8 + (o_ & 7)] = (bf16)f2bf(acc[j]); } } }
            __syncthreads(); }
        };
        auto run_transposes = [&]() {
        const int lane = TID_OF(wave_s) & 63;
        { float* scr = (float*)lds_raw + wave * 64 * 33;
          constexpr int I_IN = (D / 64) * (INW / 32), I_NA = (1024 / 64) * (D / 32), I_MO = (512 / 64) * (D / 32), I_O = (D / 64) * (D / 32);
          constexpr int I_GU = (D / 64) * (DFF / 32), I_DN = (DFF / 64) * (D / 32); constexpr int PER_L = I_IN + I_NA + I_MO + I_O; constexpr int PER_F = 2 * I_GU + I_DN; constexpr int TOT = 2 * PER_L + PER_F * 9;
          struct Desc { const float* W; const float* gain; bf16* dst; bf16* dst2; int K, N, mode, item, ldk, koff, f8; };
          auto decode = [&](int it, Desc& d) { int r = it; d.gain = nullptr; d.dst2 = nullptr; d.ldk = 0; d.koff = 0; d.f8 = 0;
              if (r < 2 * PER_L) { const int l = r / PER_L; r -= l * PER_L;
                  if (r < I_IN) { d.W = AIN(3) + (size_t)l * D * INW; d.K = D; d.N = INW; d.gain = AIN(2) + l * D; d.dst = (bf16*)(ws + OFF_WINM + l * SZ_WINM); d.dst2 = (bf16*)(ws + OFF_WINT + l * SZ_WINT); d.mode = 1; d.item = r;
                      if ((r % (INW / 32)) * 32 >= 4096) { d.f8 = 1; d.mode = 4; d.dst = (bf16*)(ws + OFF_WINM + l * SZ_WINM + OFF_WG8); }
                      else if ((r % (INW / 32)) * 32 >= 2560 && (r % (INW / 32)) * 32 < 3584) { d.f8 = 1; d.mode = 5; d.dst = (bf16*)(ws + OFF_WINT + l * SZ_WINT); }
                      else if ((r % (INW / 32)) * 32 >= 512) { d.f8 = 1; d.mode = 6; }
                      return; } r -= I_IN;
                  if (r < I_NA) { d.W = AIN(12) + (size_t)l * 1024 * D; d.K = 1024; d.N = D; d.dst = (bf16*)(ws + OFF_WALL + l * SZ_WALL); d.ldk = LDM; d.koff = 0; d.mode = 0; d.item = r; return; } r -= I_NA;
                  if (r < I_MO) { d.W = AIN(13) + (size_t)l * 512 * D; d.K = 512; d.N = D; d.dst = (bf16*)(ws + OFF_WALL + l * SZ_WALL); d.ldk = LDM; d.koff = 1024; d.mode = 0; d.item = r; return; } r -= I_MO;
                  d.W = AIN(14) + (size_t)l * D * D; d.K = D; d.N = D; d.dst = (bf16*)(ws + OFF_WO + l * SZ_WO); d.mode = 0; d.item = r; d.f8 = (l == WO8_LAYER); return; }
              r -= 2 * PER_L; const int mm = r / PER_F; r -= mm * PER_F; d.f8 = mm > 0;
              bf16* dgu = (bf16*)(ws + (mm == 0 ? OFF_WGU0 : OFF_WGUE + (size_t)(mm - 1) * (SZ_WGU / 2))); bf16* dd = (bf16*)(ws + (mm == 0 ? OFF_WD0 : OFF_WDE + (size_t)(mm - 1) * (SZ_WD / 2)));
              if (r < I_GU) { d.W = mm == 0 ? AIN(16) : AIN(20) + (size_t)(mm - 1) * D * DFF; d.K = D; d.N = DFF; d.gain = AIN(15) + (mm == 0 ? 0 : D); d.dst = dgu; d.mode = 2; d.item = r; return; } r -= I_GU;
              if (r < I_GU) { d.W = mm == 0 ? AIN(17) : AIN(21) + (size_t)(mm - 1) * D * DFF; d.K = D; d.N = DFF; d.gain = AIN(15) + (mm == 0 ? 0 : D); d.dst = dgu; d.mode = 3; d.item = r; return; } r -= I_GU;
              d.W = mm == 0 ? AIN(18) : AIN(22) + (size_t)(mm - 1) * DFF * D; d.K = DFF; d.N = D; d.dst = dd; d.mode = 0; d.item = r; };
          auto fin = [&](const Desc& dc, const TrLoad& tc, int sub) { const int item = dc.item + sub;
              if (dc.f8) { if (dc.mode == 4) transpose_finish8<4>(tc, dc.K, dc.N, dc.gain, 64.f, (unsigned char*)dc.dst, scr, item, lane); else if (dc.mode == 5) transpose_finish8<5>(tc, dc.K, dc.N, dc.gain, 64.f, (unsigned char*)dc.dst, scr, item, lane); else if (dc.mode == 6) transpose_finish8<6>(tc, dc.K, dc.N, dc.gain, 64.f, (unsigned char*)dc.dst, scr, item, lane); else if (dc.mode == 0) transpose_finish8<0>(tc, dc.K, dc.N, dc.gain, 64.f, (unsigned char*)dc.dst, scr, item, lane); else if (dc.mode == 2) transpose_finish8<2>(tc, dc.K, dc.N, dc.gain, 64.f, (unsigned char*)dc.dst, scr, item, lane); else transpose_finish8<3>(tc, dc.K, dc.N, dc.gain, 64.f, (unsigned char*)dc.dst, scr, item, lane); }
              else if (dc.mode == 0) transpose_finish<0>(tc, dc.K, dc.N, dc.gain, dc.dst, dc.dst2, scr, item, lane, dc.ldk, dc.koff);
              else if (dc.mode == 1) transpose_finish<1>(tc, dc.K, dc.N, dc.gain, dc.dst, dc.dst2, scr, item, lane);
              else if (dc.mode == 2) transpose_finish<2>(tc, dc.K, dc.N, dc.gain, dc.dst, dc.dst2, scr, item, lane);
              else transpose_finish<3>(tc, dc.K, dc.N, dc.gain, dc.dst, dc.dst2, scr, item, lane); };
          for (int it4r = gw; it4r < TOT / 4; it4r += NGW) { const int it4 = TOT / 4 - 1 - it4r; Desc d; decode(it4 * 4, d);
              TrLoad t4[4]; transpose_load4(d.W, d.N, d.item >> 2, lane, t4);
              fin(d, t4[0], 0); fin(d, t4[1], 1); fin(d, t4[2], 2); fin(d, t4[3], 3); }
          __syncthreads(); }
        };
        (void)helpers_first; run_transposes(); run_helpers();
    }
    SEAM(0);

    for (int l = 0; l < 2; ++l) {
        const int pb = 1 + 8 * l;
        if (IN(pb + 0)) { PHASE_BEGIN(); float* xss_in = xssA;
            { pg8::Sched<0> Sd{(const char*)(ws + OFF_XB8), (const char*)(ws + OFF_WINM + l * SZ_WINM + OFF_WG8), D / 2, (unsigned)(D / 2), (unsigned)(D / 2), S / 256, 6144 / 256, G, bx, nullptr, 0, nullptr};
              pg8::EpGates8 E{xss_in, (unsigned char*)gt}; pg8::gemm_phase(lds, Sd, E, wave_s); }
            { pg8::Sched<0> Sd{(const char*)(ws + OFF_XB8), (const char*)(ws + OFF_WINM + l * SZ_WINM), D / 2, (unsigned)(D / 2), (unsigned)(D / 2), S / 256, 2560 / 256, G, bx, nullptr, 0, nullptr};
              pg8::EpInMain<true> E{xss_in, qn, kn, qm, AIN(4) + l * HD, AIN(5) + l * HD, AIN(9) + l * HD};
              pg8::gemm_phase(lds, Sd, E, wave_s); }
            { pg8::Sched<0> Sd{(const char*)(ws + OFF_WINT + l * SZ_WINT), (const char*)(ws + OFF_XB8), D / 2, (unsigned)(D / 2), (unsigned)(D / 2), 1024 / 256, S / 256, G, bx, nullptr, 0, nullptr};
              pg8::EpT<0, true> E{xss_in, vT}; pg8::gemm_phase(lds, Sd, E, wave_s); }
            { pg8::Sched<1> Sd{(const char*)(ws + OFF_WINT + l * SZ_WINT) + (size_t)1024 * D * 2, (const char*)xb, D, (unsigned)D, (unsigned)D, 512 / 256, S / 256, G, (bx + G / 2) % G, nullptr, 0, nullptr};
              pg8::EpT<1> E{xss_in, finT}; pg8::gemm_phase(lds, Sd, E, wave_s); }
        }
        SEAM(pb + 0);
        if (IN(pb + 1)) { PHASE_BEGIN();
            unsigned* f1cnt = ctl + CW_F1 + 64 * l;
            { const int lane = TID_OF(wave_s) & 63; for (int u = gw; u < 2048; u += NGW) f1_wave(finT, (const bf16*)(ws + OFF_DFTC), (const bf16*)(ws + OFF_DFTS), (const float*)(ws + OFF_TW), (bf16*)(ws + OFF_B2P), (bf16*)(ws + OFF_B2Q), u, lane); }
            asm volatile("s_waitcnt vmcnt(0)" ::: "memory");
            __syncthreads();
            if (wave_s == 0 && lane_id_() == 0) { __builtin_amdgcn_fence(__ATOMIC_RELEASE, "agent"); asm volatile("s_waitcnt vmcnt(0)" ::: "memory");
                (void)__hip_atomic_fetch_add((GAS unsigned*)f1cnt, 1u, __ATOMIC_RELAXED, __HIP_MEMORY_SCOPE_AGENT); }
            { const int lane = TID_OF(wave_s) & 63;
            for (int u = gw; u < ROWS * 8 * 2; u += NGW) { const int half = u & 1, hd = (u >> 1) & 7, qr = u >> 4; int rstart = qr - 4; rstart = rstart < 0 ? 0 : (rstart > ROWS - 8 ? ROWS - 8 : rstart); const int tok0 = qr * GW + half * 32;
                attn_wave_f<true>(qn + (size_t)tok0 * 1024 + hd * HD, 1024, kn + (size_t)hd * 512 * 4096, vT + (size_t)hd * 512 * 4096, 2 * rstart, 16, (const float*)(ws + OFF_RPBP) + ((size_t)(l * 8 + hd)) * 15 * 128, qr, rstart, half, actm + (size_t)tok0 * LDM + hd * HD, LDM, lane); } }
            { const int lane = TID_OF(wave_s) & 63;
            for (int u = gw; u < (S / 32) * 4; u += NGW) { const int hd = u & 3, qb = u >> 2; const int tok0 = qb * 32;
                const bf16* km = (const bf16*)(ws + OFF_KMEM) + (size_t)(l * 4 + hd) * NMEM * HD; const bf16* vm = (const bf16*)(ws + OFF_VMEMT) + (size_t)(l * 4 + hd) * HD * NMEM;
                attn_wave_f<false>(qm + (size_t)tok0 * 512 + hd * HD, 512, km, vm, 0, 8, nullptr, 0, 0, 0, actm + (size_t)tok0 * LDM + 1024 + hd * HD, LDM, lane); } }
            if (wave_s == 0) {
                if (lane_id_() == 0) { unsigned sp = 0; while (__hip_atomic_load((GAS unsigned*)f1cnt, __ATOMIC_RELAXED, __HIP_MEMORY_SCOPE_AGENT) < (unsigned)G) { __builtin_amdgcn_s_sleep(2); if (++sp > (1u << 20)) break; } }
                __builtin_amdgcn_fence(__ATOMIC_ACQUIRE, "agent"); asm volatile("s_waitcnt vmcnt(0)" ::: "memory"); }
            __syncthreads();
            { const int lane = TID_OF(wave_s) & 63; for (int u = gw; u < 2048; u += NGW) f2_wave((const bf16*)(ws + OFF_B2P), (const bf16*)(ws + OFF_B2Q), (const bf16*)(ws + OFF_DFTC), (const bf16*)(ws + OFF_DFTS), actm + 1536, u, lane, LDM); }
        }
        if (IN(pb + 1) && IN(pb + 3)) xcd_barrier(bar);
        if (IN(pb + 3)) { PHASE_BEGIN(); pg8::Sched<0> Sd{(const char*)actm, (const char*)(ws + OFF_WALL + l * SZ_WALL), LDM, (unsigned)LDM, (unsigned)LDM, S / 256, D / 256, G, bx, nullptr, 0, nullptr}; if (l == WO8_LAYER) { pg8::EpMerge<true> E{(const unsigned char*)gt, mg}; pg8::gemm_phase(lds, Sd, E, wave_s); } else { pg8::EpMerge<false> E{(const unsigned char*)gt, mg}; pg8::gemm_phase(lds, Sd, E, wave_s); } }
        SEAM(pb + 3);
        if (IN(pb + 4)) { PHASE_BEGIN(); const int kk = (l == WO8_LAYER) ? D / 2 : D;
            pg8::Sched<0> Sd{(const char*)mg, (const char*)(ws + OFF_WO + l * SZ_WO), kk, (unsigned)kk, (unsigned)kk, S / 256, D / 256, G, bx, nullptr, 0, nullptr};
            if (l == 0) { if (WO8_LAYER == 0) { pg8::EpRes<0, 1024> E{xb, xssB, nullptr}; pg8::gemm_phase(lds, Sd, E, wave_s); } else { pg8::EpRes<0> E{xb, xssB, nullptr}; pg8::gemm_phase(lds, Sd, E, wave_s); } }
            else { if (WO8_LAYER == 1) { pg8::EpRes<1, 1024> E{xb, nullptr, ws + OFF_XB8}; pg8::gemm_phase(lds, Sd, E, wave_s); } else { pg8::EpRes<1> E{xb, nullptr, ws + OFF_XB8}; pg8::gemm_phase(lds, Sd, E, wave_s); } } }
        if (l == 0) {
            if (IN(pb + 4) && IN(pb + 6)) xcd_barrier(bar);
            if (IN(pb + 6)) { PHASE_BEGIN(); pg8::Sched<0> Sd{(const char*)xb, (const char*)(ws + OFF_WGU0), D, (unsigned)D, (unsigned)D, S / 256, 2 * DFF / 256, G, bx, nullptr, 0, nullptr};
                pg8::EpGU<0> E{xssB, nullptr, nullptr, hm, mt}; pg8::gemm_phase(lds, Sd, E, wave_s); }
            SEAM(pb + 6);
            if (IN(pb + 7)) { PHASE_BEGIN(); pg8::Sched<0> Sd{(const char*)hm, (const char*)(ws + OFF_WD0), DFF, (unsigned)DFF, (unsigned)DFF, S / 256, D / 256, G, bx, nullptr, 0, nullptr};
                pg8::EpRes<1> E{xb, xssA, ws + OFF_XB8}; pg8::gemm_phase(lds, Sd, E, wave_s); }
            SEAM(pb + 7);
        } else {
            SEAM(pb + 4);
            if (IN(pb + 5)) { PHASE_BEGIN();
                const float* g = AIN(15) + D; const float* wr_ = AIN(19); unsigned* cnt = ctl + CW_CNT; int* tokl = (int*)(ws + OFF_TOKL); float* wtl = (float*)(ws + OFF_WTL); float* rst = (float*)(ws + OFF_RSTOK);
                LAS f32x4* wA = (LAS f32x4*)lds; LAS f32x4* wB = wA + 2048;
                for (int k = tid; k < D; k += 512) { const float gk = g[k]; const f32x4 w0 = *(const f32x4*)(wr_ + (size_t)k * 8) * gk, w1 = *(const f32x4*)(wr_ + (size_t)k * 8 + 4) * gk; const int p = (k & 3) * 512 + (k >> 2); wA[p] = w0; wB[p] = w1; }
                __syncthreads();
                for (int t = gw; t < S; t += NGW) { const bf16* xr = xb + (size_t)t * D; float ss = 0.f; float lg[8] = {0, 0, 0, 0, 0, 0, 0, 0};
#pragma unroll
                    for (int j = 0; j < 8; ++j) { const int k0 = 4 * lane + 256 * j; const f32x4 xv = pg8::bf4_to_f32(*(const u32x2*)(xr + k0));
#pragma unroll
                        for (int e4 = 0; e4 < 4; ++e4) { const float xg = xv[e4]; ss += xg * xg; const f32x4 w0 = wA[e4 * 512 + lane + 64 * j], w1 = wB[e4 * 512 + lane + 64 * j];
                            lg[0] += xg * w0[0]; lg[1] += xg * w0[1]; lg[2] += xg * w0[2]; lg[3] += xg * w0[3]; lg[4] += xg * w1[0]; lg[5] += xg * w1[1]; lg[6] += xg * w1[2]; lg[7] += xg * w1[3]; } }
                    ss = wave_sum(ss); const float rs = 1.f / sqrtf(ss * (1.f / D) + EPS);
#pragma unroll
                    for (int e = 0; e < 8; ++e) lg[e] = wave_sum(lg[e]) * rs;
                    int e0 = 0; float l0 = lg[0];
#pragma unroll
                    for (int e = 1; e < 8; ++e) if (lg[e] > l0) { l0 = lg[e]; e0 = e; }
                    int e1 = 0; float l1 = -3.0e38f;
#pragma unroll
                    for (int e = 0; e < 8; ++e) if (e != e0 && lg[e] > l1) { l1 = lg[e]; e1 = e; }
                    const float w1 = 1.f / (1.f + __expf(l0 - l1)), w0 = 1.f - w1;
                    if (lane == 0) { rst[t] = rs; unsigned s0 = atomicAdd(cnt + e0, 1u); tokl[e0 * CAP + s0] = t; unsigned s1 = atomicAdd(cnt + e1, 1u); tokl[e1 * CAP + s1] = t; wtl[e0 * CAP + s0] = rs; wtl[e1 * CAP + s1] = rs;
                        int* tsl = (int*)(ws + OFF_TOKSLOT); float* tw_ = (float*)(ws + OFF_TOKW); tsl[2 * t] = e0 * CAP + (int)s0; tsl[2 * t + 1] = e1 * CAP + (int)s1; tw_[2 * t] = w0; tw_[2 * t + 1] = w1; } }
            }
            SEAM(pb + 5);
            if (IN(pb + 6)) { PHASE_BEGIN(); moe_tables(mt, ctl + CW_CNT, tid);
                pg8::Sched<2> Sd{(const char*)(ws + OFF_XB8), (const char*)(ws + OFF_WGUE), D / 2, (unsigned)(D / 2), (unsigned)(D / 2), 0, 2 * DFF / 256, G, bx, (const int*)(ws + OFF_TOKL), SZ_WGU / 2, mt};
                pg8::EpGU8 E{(const float*)(ws + OFF_WTL), (const int*)(ws + OFF_TOKL), (unsigned char*)hm, mt}; pg8::gemm_phase(lds, Sd, E, wave_s); }
            SEAM(pb + 6);
            if (IN(pb + 7)) { PHASE_BEGIN(); moe_tables(mt, ctl + CW_CNT, tid);
                pg8::Sched<3> Sd{(const char*)hm, (const char*)(ws + OFF_WDE), DFF / 2, (unsigned)(DFF / 2), (unsigned)(DFF / 2), 0, D / 256, G, bx, (const int*)(ws + OFF_TOKL), SZ_WD / 2, mt};
                pg8::EpMoeY E{(bf16*)(ws + OFF_YBUF)}; pg8::gemm_phase(lds, Sd, E, wave_s); }
            SEAM(pb + 7);
            if (IN(pb + 8)) { PHASE_BEGIN();
                const unsigned* cnt = ctl + CW_CNT; const int* tsl = (const int*)(ws + OFF_TOKSLOT); const float* tw_ = (const float*)(ws + OFF_TOKW); const bf16* yb = (const bf16*)(ws + OFF_YBUF); float* outp = AOUT;
                int tstart[8]; { int ts = 0;
#pragma unroll
                    for (int e = 0; e < 8; ++e) { tstart[e] = ts; ts += ((int)cnt[e] + 255) >> 8; } }
                for (int t = gw; t < S; t += NGW) { const int v0 = tsl[2 * t], v1 = tsl[2 * t + 1]; const float w0 = tw_[2 * t], w1 = tw_[2 * t + 1];
                    const int e0 = v0 >> 14, e1 = v1 >> 14; int ts0 = 0, ts1 = 0;
#pragma unroll
                    for (int e = 0; e < 8; ++e) { ts0 = (e == e0) ? tstart[e] : ts0; ts1 = (e == e1) ? tstart[e] : ts1; }
                    const bf16* y0 = yb + (size_t)(256 * ts0 + (v0 & 16383)) * D; const bf16* y1 = yb + (size_t)(256 * ts1 + (v1 & 16383)) * D; float* o = outp + (size_t)t * D; const bf16* hx = xb + (size_t)t * D;
#pragma unroll
                    for (int j = 0; j < 8; ++j) { const int c = 4 * lane + 256 * j; f32x4 x = pg8::bf4_to_f32(*(const u32x2*)(hx + c)); const f32x4 a = pg8::bf4_to_f32(*(const u32x2*)(y0 + c)), b2 = pg8::bf4_to_f32(*(const u32x2*)(y1 + c));
                        x = x + a * w0 + b2 * w1; *(f32x4*)(o + c) = x; } }
            }
        }
    }
#undef IN
#undef SEAM
}

#ifndef MK_PER_PHASE
#define MK_PER_PHASE 0
#endif
extern "C" void kernel_launch(void* const* d_in, const int* in_sizes, int n_in, void* d_out, int out_size, void* d_ws, size_t ws_size, hipStream_t stream) {
    if (n_in != 23 || out_size != S * D || ws_size < WS_NEED) { fprintf(stderr, "kernel_launch: unexpected shapes/ws (%d inputs, out %d, ws %zu, need %zu)\n", n_in, out_size, ws_size, (size_t)WS_NEED); return; }
    static int grid = 0;
    if (grid == 0) { int dev = 0, cus = 0;
        if (hipGetDevice(&dev) != hipSuccess || hipDeviceGetAttribute(&cus, hipDeviceAttributeMultiprocessorCount, dev) != hipSuccess) { grid = -1; return; }
        if (hipFuncSetAttribute((const void*)mega, hipFuncAttributeMaxDynamicSharedMemorySize, LDS_BYTES) != hipSuccess) { fprintf(stderr, "kernel_launch: hipFuncSetAttribute failed\n"); grid = -1; return; }
        int per_cu = 0; (void)hipOccupancyMaxActiveBlocksPerMultiprocessor(&per_cu, (const void*)mega, 512, LDS_BYTES); (void)hipGetLastError();
        if (per_cu < 1) fprintf(stderr, "kernel_launch: occupancy query reports %d blocks per CU\n", per_cu);
        grid = cus; }
    if (grid < 0) return;
    (void)hipMemsetAsync((char*)d_ws + OFF_CTL, 0, MiB, stream);
    MArgs a{}; for (int i = 0; i < 23; ++i) a.ptr[i] = d_in[i]; a.ptr[23] = d_out; a.ptr[24] = d_ws;
#if MK_PER_PHASE
    { int li = 0; for (int ph = 0; ph < NPHASE; ++ph) { if (ph == 6 || ph == 3 || ph == 11) continue; a.ph_lo = ph; a.ph_hi = ph + 1; a.li = li++; hipLaunchKernelGGL(mega, dim3(grid), dim3(512), LDS_BYTES, stream, a); } }
#elif defined(MK_DUP_MASK)
    { int li = 0, lo = 0;
      for (int ph = 0; ph < NPHASE; ++ph) if ((MK_DUP_MASK >> ph) & 1) {
          a.ph_lo = lo; a.ph_hi = ph + 1; a.li = li++; hipLaunchKernelGGL(mega, dim3(grid), dim3(512), LDS_BYTES, stream, a);
          a.ph_lo = ph; a.ph_hi = ph + 1; a.li = li++; hipLaunchKernelGGL(mega, dim3(grid), dim3(512), LDS_BYTES, stream, a);
          lo = ph + 1; }
      if (lo < NPHASE) { a.ph_lo = lo; a.ph_hi = NPHASE; a.li = li++; hipLaunchKernelGGL(mega, dim3(grid), dim3(512), LDS_BYTES, stream, a); } }
#elif defined(MK_DUP_LO)
    a.ph_lo = 0; a.ph_hi = MK_DUP_HI + 1; a.li = 0; hipLaunchKernelGGL(mega, dim3(grid), dim3(512), LDS_BYTES, stream, a);
    a.ph_lo = MK_DUP_LO; a.ph_hi = MK_DUP_HI + 1; a.li = 1; hipLaunchKernelGGL(mega, dim3(grid), dim3(512), LDS_BYTES, stream, a);
    if (MK_DUP_HI + 1 < NPHASE) { a.ph_lo = MK_DUP_HI + 1; a.ph_hi = NPHASE; a.li = 2; hipLaunchKernelGGL(mega, dim3(grid), dim3(512), LDS_BYTES, stream, a); }
#else
    a.ph_lo = 0; a.ph_hi = NPHASE; a.li = 0; hipLaunchKernelGGL(mega, dim3(grid), dim3(512), LDS_BYTES, stream, a);
#endif
}
```

```cpp
#include <hip/hip_runtime.h>
#include <cstdio>
#include <cstdint>

typedef unsigned short bf16;
typedef short bf16x8 __attribute__((ext_vector_type(8)));
typedef float f32x4 __attribute__((ext_vector_type(4)));
typedef float f32x16 __attribute__((ext_vector_type(16)));
typedef unsigned u32x4 __attribute__((ext_vector_type(4)));
typedef unsigned u32x2 __attribute__((ext_vector_type(2)));

constexpr int S = 16384, D = 2048, GW = 64, ROWS = 256, HD = 128;
constexpr int NMEM = 256;
constexpr int INW = 10240;
constexpr int DFF = 5632, NE = 8;
constexpr int NMAIN = 8704;
constexpr int NT = 1536;
constexpr float EPS = 1e-6f;
constexpr float LOG2E = 1.4426950408889634f;
constexpr float QSCALE = 0.08838834764831845f * LOG2E;
constexpr int CAP = 16384;
constexpr int HROWS = 2 * S + NE * 256;

constexpr size_t MiB = 1u << 20;
constexpr size_t OFF_CTL = 0;
constexpr size_t OFF_DFTC = 1 * MiB;
constexpr size_t OFF_DFTS = OFF_DFTC + 32768;
constexpr size_t OFF_TW = OFF_DFTS + 32768;
constexpr size_t OFF_CS128 = OFF_TW + 131072;
constexpr size_t OFF_RPBP = MiB + 524288;
constexpr size_t OFF_KMEM = 2 * MiB;
constexpr size_t OFF_VMEMT = OFF_KMEM + 524288;
constexpr size_t OFF_TOKL = 3 * MiB;
constexpr size_t OFF_WTL = OFF_TOKL + 524288;
constexpr size_t OFF_RSTOK = OFF_WTL + 524288;
constexpr size_t OFF_TOKSLOT = OFF_RSTOK + 131072;
constexpr size_t OFF_TOKW = OFF_TOKSLOT + 131072;
constexpr size_t OFF_RSX = 5 * MiB;
constexpr size_t OFF_XSS = 6 * MiB;
constexpr size_t OFF_XSS2 = 8 * MiB;
constexpr size_t OFF_W = 10 * MiB;
constexpr size_t SZ_WINM = (size_t)NMAIN * D * 2, SZ_WINT = (size_t)NT * D * 2, SZ_WFO2 = (size_t)D * 1024 * 2, SZ_WNA = (size_t)D * 1024 * 2,
                 SZ_WMO = (size_t)D * 512 * 2, SZ_WO = (size_t)D * D * 2, SZ_WGU = (size_t)2 * DFF * D * 2, SZ_WD = (size_t)D * DFF * 2;
constexpr size_t OFF_WINM = OFF_W;
constexpr size_t OFF_WINT = OFF_WINM + 2 * SZ_WINM;
constexpr size_t OFF_WFO2 = OFF_WINT + 2 * SZ_WINT;
constexpr size_t OFF_WNA = OFF_WFO2 + 2 * SZ_WFO2;
constexpr size_t OFF_WMO = OFF_WNA + 2 * SZ_WNA;
constexpr size_t OFF_WO = OFF_WMO + 2 * SZ_WMO;
constexpr size_t OFF_WGU0 = OFF_WO + 2 * SZ_WO;
constexpr size_t OFF_WD0 = OFF_WGU0 + SZ_WGU;
constexpr size_t OFF_WGUE = OFF_WD0 + SZ_WD;
constexpr size_t OFF_WDE = OFF_WGUE + 8 * SZ_WGU;
constexpr size_t OFF_WEND = OFF_WDE + 8 * SZ_WD;
constexpr size_t OFF_XB = (OFF_WEND + MiB - 1) / MiB * MiB;
constexpr size_t OFF_ACT = OFF_XB + (size_t)S * D * 2;
constexpr size_t OFF_QN = OFF_ACT;
constexpr size_t OFF_KN = OFF_QN + (size_t)S * 1024 * 2;
constexpr size_t OFF_VT = OFF_KN + (size_t)S * 1024 * 2;
constexpr size_t OFF_QM = OFF_VT + (size_t)S * 1024 * 2;
constexpr size_t OFF_GT = OFF_QM + (size_t)S * 512 * 2;
constexpr size_t OFF_FINT = OFF_GT + (size_t)S * 6144 * 2;
constexpr size_t OFF_B2P = OFF_FINT + (size_t)S * 512 * 2;
constexpr size_t OFF_B2Q = OFF_B2P + (size_t)S * 512 * 2;
constexpr size_t OFF_YM = OFF_B2Q + (size_t)S * 512 * 2;
constexpr size_t OFF_ONA = OFF_YM + (size_t)S * 1024 * 2;
constexpr size_t OFF_OMEM = OFF_ONA + (size_t)S * 1024 * 2;
constexpr size_t OFF_MPART = OFF_OMEM + (size_t)S * 512 * 2;
constexpr size_t OFF_MG = OFF_MPART + (size_t)S * D * 4;
constexpr size_t OFF_ACTEND = OFF_MG + (size_t)S * D * 2;
constexpr size_t OFF_HMID = OFF_ACT;
static_assert(OFF_HMID + (size_t)HROWS * DFF * 2 <= OFF_ACTEND, "hmid overlay");
constexpr size_t OFF_YBUF = OFF_HMID + (size_t)HROWS * DFF * 2;
static_assert(OFF_YBUF + (size_t)HROWS * D * 2 <= OFF_ACTEND, "ybuf");
constexpr size_t OFF_XB8 = OFF_ACTEND;
constexpr size_t OFF_WG8 = (size_t)2560 * D * 2;
static_assert(OFF_WG8 + (size_t)6144 * D <= SZ_WINM, "gate weights");
constexpr size_t WS_NEED = OFF_XB8 + (size_t)S * D;
constexpr size_t OFF_ACTM = OFF_YM;
constexpr int LDM = 2560;
constexpr size_t OFF_WALL = OFF_WFO2;
constexpr size_t SZ_WALL = (size_t)D * LDM * 2;
static_assert(OFF_ACTM + (size_t)S * LDM * 2 == OFF_MPART && OFF_WALL + 2 * SZ_WALL == OFF_WO, "combined out-proj operands");
constexpr int CW_CNT = 64;

struct Params { const float* in[23]; float* out; unsigned char* ws; };

__device__ __forceinline__ unsigned f2bf(float f) { unsigned u = __float_as_uint(f); return (u + 0x7fffu + ((u >> 16) & 1u)) >> 16; }
__device__ __forceinline__ unsigned pk2(float lo, float hi) { return f2bf(lo) | (f2bf(hi) << 16); }
__device__ __forceinline__ unsigned pk2hw(float lo, float hi) { unsigned r; asm("s_nop 1\n\tv_cvt_pk_bf16_f32 %0, %1, %2" : "=v"(r) : "v"(lo), "v"(hi)); return r; }
__device__ __forceinline__ float bf2f(unsigned b) { return __uint_as_float(b << 16); }
__device__ __forceinline__ int lane_id_() { int l; asm volatile("v_mbcnt_lo_u32_b32 %0, -1, 0\n\tv_mbcnt_hi_u32_b32 %0, -1, %0" : "=v"(l)); return l; }
__device__ __forceinline__ int zero_i_() { int z; asm volatile("v_mov_b32 %0, 0" : "=v"(z)); return z; }
__device__ __forceinline__ float zero_f_() { float z; asm volatile("v_mov_b32 %0, 0" : "=v"(z)); return z; }
__device__ __forceinline__ float shflx(float v, int k) { return __int_as_float(__builtin_amdgcn_ds_bpermute((lane_id_() ^ k) << 2, __float_as_int(v))); }
__device__ __forceinline__ float wave_sum(float v) {
#pragma unroll
    for (int o = 1; o < 64; o <<= 1) v += shflx(v, o);
    return v;
}
__device__ __forceinline__ float sigmoidf_(float z) { return __builtin_amdgcn_rcpf(1.f + __builtin_amdgcn_exp2f(-1.4426950408889634f * z)); }
__device__ __forceinline__ f32x4 sigmoid4_(const f32x4 z) { f32x4 t;
#pragma unroll
    for (int q = 0; q < 4; ++q) t[q] = __builtin_amdgcn_exp2f(-1.4426950408889634f * z[q]);
#pragma unroll
    for (int q = 0; q < 4; ++q) t[q] = 1.f + t[q];
#pragma unroll
    for (int q = 0; q < 4; ++q) t[q] = __builtin_amdgcn_rcpf(t[q]);
    return t; }
#define LDS_WAIT() asm volatile("s_waitcnt lgkmcnt(0)" ::: "memory")

struct TrLoad { f32x4 v[8]; };
__device__ __forceinline__ void transpose_load(const float* W, int N, int item, int lane, TrLoad& t) {
    const int nblk = N / 32, kb = item / nblk, nb = item % nblk, k0 = 64 * kb, n0 = 32 * nb;
    const float* src = W + (size_t)(k0 + (lane >> 3)) * N + n0 + 4 * (lane & 7);
#pragma unroll
    for (int i = 0; i < 8; ++i) t.v[i] = *(const f32x4*)(src + (size_t)(8 * i) * N);
}
__device__ __forceinline__ void transpose_load4(const float* W, int N, int item4, int lane, TrLoad (&t)[4]) {
    const int nblk4 = N / 128, kb = item4 / nblk4, nb4 = item4 % nblk4, k0 = 64 * kb, n0 = 128 * nb4;
    const float* src = W + (size_t)(k0 + (lane >> 3)) * N + n0 + 4 * (lane & 7);
#pragma unroll
    for (int sb = 0; sb < 4; ++sb)
#pragma unroll
        for (int i = 0; i < 8; ++i) t[sb].v[i] = *(const f32x4*)(src + (size_t)(8 * i) * N + 32 * sb);
}
template <int MODE>
__device__ __forceinline__ void transpose_finish(const TrLoad& t, int K, int N, const float* gain, bf16* dst, bf16* dst2, float* scr, int item, int lane, int ldk = 0, int koff = 0) {
    if (ldk == 0) ldk = K;
    const int nblk = N / 32, kb = item / nblk, nb = item % nblk, k0 = 64 * kb, n0 = 32 * nb;
#pragma unroll
    for (int i = 0; i < 8; ++i) { const int kk = 8 * i + (lane >> 3); f32x4 v = t.v[i]; if (gain) v = v * gain[k0 + kk]; float* s = scr + kk * 33 + 4 * (lane & 7); s[0] = v[0]; s[1] = v[1]; s[2] = v[2]; s[3] = v[3]; }
    LDS_WAIT();
    const int c = lane & 7;
#pragma unroll
    for (int j = 0; j < 4; ++j) { const int n = (lane >> 3) + 8 * j; const float* s = scr + (8 * c) * 33 + n;
        u32x4 o; o.x = pk2hw(s[0 * 33], s[1 * 33]); o.y = pk2hw(s[2 * 33], s[3 * 33]); o.z = pk2hw(s[4 * 33], s[5 * 33]); o.w = pk2hw(s[6 * 33], s[7 * 33]);
        bf16* base = dst; int row; const int nn = n0 + n;
        if (MODE == 0) row = nn;
        else if (MODE == 1) {
            if (nn < 512) { base = dst2; row = 1024 + nn; }
            else if (nn < 1536) { row = nn - 512; }
            else if (nn < 2560) { row = 1024 + (nn - 1536); }
            else if (nn < 3584) { base = dst2; row = nn - 2560; }
            else if (nn < 4096) { row = 2048 + (nn - 3584); }
            else { row = 2560 + (nn - 4096); } }
        else { row = 8 * (nn >> 2) + (nn & 3) + (MODE == 3 ? 4 : 0); }
        *(u32x4*)(base + (size_t)row * ldk + koff + k0 + 8 * c) = o; }
    LDS_WAIT();
}
template <int MODE>
__device__ __forceinline__ void transpose_finish8(const TrLoad& t, int K, int N, const float* gain, float scale, unsigned char* dst, float* scr, int item, int lane) {
    const int nblk = N / 32, kb = item / nblk, nb = item % nblk, k0 = 64 * kb, n0 = 32 * nb;
#pragma unroll
    for (int i = 0; i < 8; ++i) { const int kk = 8 * i + (lane >> 3); f32x4 v = t.v[i] * scale; if (gain) v = v * gain[k0 + kk]; float* s = scr + kk * 33 + 4 * (lane & 7); s[0] = v[0]; s[1] = v[1]; s[2] = v[2]; s[3] = v[3]; }
    LDS_WAIT();
    const int c = lane & 7;
#pragma unroll
    for (int j = 0; j < 4; ++j) { const int n = (lane >> 3) + 8 * j; const float* s = scr + (8 * c) * 33 + n;
        int w0 = 0, w1 = 0;
        w0 = __builtin_amdgcn_cvt_pk_fp8_f32(s[0 * 33], s[1 * 33], w0, false); w0 = __builtin_amdgcn_cvt_pk_fp8_f32(s[2 * 33], s[3 * 33], w0, true);
        w1 = __builtin_amdgcn_cvt_pk_fp8_f32(s[4 * 33], s[5 * 33], w1, false); w1 = __builtin_amdgcn_cvt_pk_fp8_f32(s[6 * 33], s[7 * 33], w1, true);
        const int nn = n0 + n; const int row = (MODE == 0) ? nn : (MODE == 4) ? (nn - 4096) : (MODE == 5) ? (nn - 2560) : (MODE == 6) ? (nn < 2560 ? nn - 512 : nn - 1536) : (8 * (nn >> 2) + (nn & 3) + (MODE == 3 ? 4 : 0));
        u32x2 o; o.x = (unsigned)w0; o.y = (unsigned)w1; *(u32x2*)(dst + (size_t)row * K + k0 + 8 * c) = o; }
    LDS_WAIT();
}
__device__ __forceinline__ int prow32(int r) { return (r & ~12) | ((r & 4) << 1) | ((r & 8) >> 1); }
template <bool NA>
__device__ __forceinline__ void attn_wave_f(const bf16* Q, int qs, const bf16* KF, const bf16* VF, int T0, int ntiles, const float* rpb, int qrow, int rstart, int chalf, bf16* O, int os, int lane) {
    const int r = lane & 31, h = lane >> 5;
    bf16x8 qf[8];
#pragma unroll
    for (int s = 0; s < 8; ++s) qf[s] = *(const bf16x8*)(Q + (size_t)r * qs + 16 * s + 8 * h);
    f32x16 o[4];
#pragma unroll
    for (int d = 0; d < 4; ++d)
#pragma unroll
        for (int q = 0; q < 16; ++q) o[d][q] = 0.f;
    float m = -3.0e38f, lsum = 0.f;
    const int c = chalf * 32 + r; const int cs = c - 8 < 0 ? 0 : (c - 8 > 48 ? 48 : c - 8);
    const bf16* kp = KF + (size_t)T0 * 4096 + lane * 8; const bf16* vp = VF + (size_t)T0 * 4096 + lane * 8;
    bf16x8 kf[8];
#pragma unroll
    for (int s = 0; s < 8; ++s) kf[s] = *(const bf16x8*)(kp + s * 512);
    for (int t = 0; t < ntiles; ++t) {
        bf16x8 vf[4][2];
#pragma unroll
        for (int d = 0; d < 4; ++d)
#pragma unroll
            for (int s = 0; s < 2; ++s) vf[d][s] = *(const bf16x8*)(vp + (size_t)t * 4096 + (d * 2 + s) * 512);
        float bvv[16];
        if (NA) { const int ro = rstart + (t >> 1) - qrow + 7; const float* bp = rpb + ro * 128 + (48 + 15 + 32 * (t & 1) + 8 * h - c);
#pragma unroll
            for (int q = 0; q < 16; ++q) bvv[q] = bp[16 * (q >> 3) + (q & 7)]; }
        f32x16 sacc;
#pragma unroll
        for (int q = 0; q < 16; ++q) sacc[q] = 0.f;
#pragma unroll
        for (int s = 0; s < 8; ++s) sacc = __builtin_amdgcn_mfma_f32_32x32x16_bf16(kf[s], qf[s], sacc, 0, 0, 0);
        if (NA) {
            asm volatile("" : "+v"(bvv[0]), "+v"(bvv[1]), "+v"(bvv[2]), "+v"(bvv[3]), "+v"(bvv[4]), "+v"(bvv[5]), "+v"(bvv[6]), "+v"(bvv[7]));
            asm volatile("" : "+v"(bvv[8]), "+v"(bvv[9]), "+v"(bvv[10]), "+v"(bvv[11]), "+v"(bvv[12]), "+v"(bvv[13]), "+v"(bvv[14]), "+v"(bvv[15]));
            const int bk = 32 * (t & 1) + 8 * h - cs;
#pragma unroll
            for (int q = 0; q < 16; ++q) { const bool ok = (unsigned)(bk + 16 * (q >> 3) + (q & 7)) < 16u;
                sacc[q] = ok ? sacc[q] + bvv[q] : -1.0e30f; } }
        { const int tn = t + 1 < ntiles ? t + 1 : t;
#pragma unroll
          for (int s = 0; s < 8; ++s) kf[s] = *(const bf16x8*)(kp + (size_t)tn * 4096 + s * 512); }
        float tmax = -3.0e38f;
#pragma unroll
        for (int q = 0; q < 16; ++q) tmax = fmaxf(tmax, sacc[q]);
        tmax = fmaxf(tmax, shflx(tmax, 32));
        const float mn = fmaxf(m, tmax); const float alpha = __builtin_amdgcn_exp2f(m - mn); m = mn;
        float ps = 0.f;
#pragma unroll
        for (int q = 0; q < 16; ++q) { sacc[q] = __builtin_amdgcn_exp2f(sacc[q] - mn); ps += sacc[q]; }
        lsum = lsum * alpha + ps;
#pragma unroll
        for (int d = 0; d < 4; ++d)
#pragma unroll
            for (int q = 0; q < 16; ++q) o[d][q] *= alpha;
        bf16x8 pf[2];
#pragma unroll
        for (int s = 0; s < 2; ++s) { u32x4 w; w.x = pk2(sacc[8 * s], sacc[8 * s + 1]); w.y = pk2(sacc[8 * s + 2], sacc[8 * s + 3]); w.z = pk2(sacc[8 * s + 4], sacc[8 * s + 5]); w.w = pk2(sacc[8 * s + 6], sacc[8 * s + 7]); pf[s] = __builtin_bit_cast(bf16x8, w); }
#pragma unroll
        for (int d = 0; d < 4; ++d)
#pragma unroll
            for (int s = 0; s < 2; ++s) o[d] = __builtin_amdgcn_mfma_f32_32x32x16_bf16(vf[d][s], pf[s], o[d], 0, 0, 0);
    }
    lsum += shflx(lsum, 32); const float inv = 1.f / lsum;
#pragma unroll
    for (int d = 0; d < 4; ++d)
#pragma unroll
        for (int q = 0; q < 4; ++q) { u32x2 w; w.x = pk2(o[d][4 * q] * inv, o[d][4 * q + 1] * inv); w.y = pk2(o[d][4 * q + 2] * inv, o[d][4 * q + 3] * inv);
            *(u32x2*)(O + (size_t)r * os + 32 * d + 8 * q + 4 * h) = w; }
}
__device__ __forceinline__ void f1_wave(const bf16* finT, const bf16* dC, const bf16* dS, const float* tw, bf16* B2P, bf16* B2Q, int rb, int lane) {
    const int r = lane & 31, h = lane >> 5; const int R0 = rb * 32, c = R0 >> 7, sf0 = R0 & 127;
    bf16x8 xf[8];
#pragma unroll
    for (int s = 0; s < 8; ++s) xf[s] = *(const bf16x8*)(finT + (size_t)(R0 + r) * 128 + 16 * s + 8 * h);
    for (int cb = 0; cb < 4; ++cb) { const int kb = cb * 32 + r;
        f32x16 ar, as;
#pragma unroll
        for (int q = 0; q < 16; ++q) { ar[q] = 0.f; as[q] = 0.f; }
#pragma unroll
        for (int s = 0; s < 8; ++s) { const bf16x8 cf = *(const bf16x8*)(dC + kb * 128 + 16 * s + 8 * h), sf = *(const bf16x8*)(dS + kb * 128 + 16 * s + 8 * h);
            ar = __builtin_amdgcn_mfma_f32_32x32x16_bf16(xf[s], cf, ar, 0, 0, 0); as = __builtin_amdgcn_mfma_f32_32x32x16_bf16(xf[s], sf, as, 0, 0, 0); }
#pragma unroll
        for (int qq = 0; qq < 4; ++qq) { float pv[4], qv[4];
#pragma unroll
            for (int e = 0; e < 4; ++e) { const int sf = sf0 + e + 8 * qq + 4 * h; const float2 t = *(const float2*)(tw + 2 * (kb * sf)); const float a = ar[4 * qq + e], b = as[4 * qq + e];
                pv[e] = t.x * a - t.y * b; qv[e] = t.x * b + t.y * a; }
            const size_t off = ((size_t)kb * 512 + c) * 128 + sf0 + 8 * qq + 4 * h;
            u32x2 w; w.x = pk2(pv[0], pv[1]); w.y = pk2(pv[2], pv[3]); *(u32x2*)(B2P + off) = w; w.x = pk2(qv[0], qv[1]); w.y = pk2(qv[2], qv[3]); *(u32x2*)(B2Q + off) = w; }
    }
}
__device__ __forceinline__ void f2_wave(const bf16* B2P, const bf16* B2Q, const bf16* dC, const bf16* dS, bf16* Ym, int rb, int lane, int ldy = 1024) {
    const int r = lane & 31, h = lane >> 5; const int R0 = rb * 32, kb = R0 >> 9, c0 = R0 & 511;
    bf16x8 pf[8], qf[8];
#pragma unroll
    for (int s = 0; s < 8; ++s) { pf[s] = *(const bf16x8*)(B2P + (size_t)(R0 + r) * 128 + 16 * s + 8 * h); qf[s] = *(const bf16x8*)(B2Q + (size_t)(R0 + r) * 128 + 16 * s + 8 * h); }
    for (int cb = 0; cb < 4; ++cb) { const int ka = cb * 32 + r;
        f32x16 yr, z;
#pragma unroll
        for (int q = 0; q < 16; ++q) { yr[q] = 0.f; z[q] = 0.f; }
#pragma unroll
        for (int s = 0; s < 8; ++s) { const bf16x8 sf = *(const bf16x8*)(dS + ka * 128 + 16 * s + 8 * h); yr = __builtin_amdgcn_mfma_f32_32x32x16_bf16(qf[s], sf, yr, 0, 0, 0); z = __builtin_amdgcn_mfma_f32_32x32x16_bf16(pf[s], sf, z, 0, 0, 0); }
#pragma unroll
        for (int q = 0; q < 16; ++q) yr[q] = -yr[q];
#pragma unroll
        for (int s = 0; s < 8; ++s) { const bf16x8 cf = *(const bf16x8*)(dC + ka * 128 + 16 * s + 8 * h); yr = __builtin_amdgcn_mfma_f32_32x32x16_bf16(pf[s], cf, yr, 0, 0, 0); z = __builtin_amdgcn_mfma_f32_32x32x16_bf16(qf[s], cf, z, 0, 0, 0); }
        const size_t tok = (size_t)128 * ka + kb;
#pragma unroll
        for (int qq = 0; qq < 4; ++qq) { const int cc = c0 + 8 * qq + 4 * h; u32x2 w;
            w.x = pk2(yr[4 * qq], yr[4 * qq + 1]); w.y = pk2(yr[4 * qq + 2], yr[4 * qq + 3]); *(u32x2*)(Ym + tok * ldy + cc) = w;
            w.x = pk2(z[4 * qq], z[4 * qq + 1]); w.y = pk2(z[4 * qq + 2], z[4 * qq + 3]); *(u32x2*)(Ym + tok * ldy + 512 + cc) = w; }
    }
}

#define LAS __attribute__((address_space(3)))
#define GAS __attribute__((address_space(1)))
#define VM_WAIT() asm volatile("s_waitcnt vmcnt(0)" ::: "memory")

#ifndef WO8_LAYER
#define WO8_LAYER 1
#endif
constexpr int RING_BYTES = 131072;
constexpr int L_MISC = RING_BYTES;
constexpr int L_RS = RING_BYTES + 256;
constexpr int L_SS = L_RS + 1024;
constexpr int L_MOE = L_SS + 8192;
constexpr int L_SL2 = 147456;
constexpr int LDS_BYTES = 147456 + 8192;
static_assert(L_MOE + 1024 <= LDS_BYTES, "LDS map");

#define TID_OF(wv) ((wv) * 64 + lane_id_())
namespace pg8 {
typedef int v8i32 __attribute__((ext_vector_type(8)));
typedef int i32x4 __attribute__((ext_vector_type(4)));
constexpr int BM = 256, BK = 64, HALF = 128, HTB = HALF * BK * 2, STAGE_BYTES = 8 * HTB, NXCD = 8, WGM = 8;
__host__ __device__ __forceinline__ int lds_byte(int r, int c) { const int st = (r >> 4) * 2 + (c >> 5), rr = r & 15, cc = c & 31, ob = rr * 64 + cc * 2; return st * 1024 + (ob ^ (((ob >> 9) & 1) << 5)); }
__host__ __device__ __forceinline__ void stage_rc(int b, int& R, int& C) { const int st = b / 1024, sb = b % 1024, swz = sb ^ (((sb >> 9) & 1) << 5); R = (st >> 1) * 16 + swz / 64; C = (st & 1) * 32 + (swz % 64) / 2; }
__host__ __device__ __forceinline__ int perm32(int rho) { const int n = rho >> 4, i = rho & 15; return 8 * (i >> 2) + 4 * n + (i & 3); }
__device__ __forceinline__ unsigned cvt_pk_bf16(float lo, float hi) { unsigned r; asm volatile("s_nop 1\n\tv_cvt_pk_bf16_f32 %0, %1, %2" : "=v"(r) : "v"(lo), "v"(hi)); return r; }

struct Unit { int pm, pn, e, rows; };

__device__ __forceinline__ bool static_unit(int i, int G, int c, int nM, int nN, int& pm, int& pn) {
    const int nwg = nM * nN; const long L = (long)i * G + c; if (L >= nwg) return false;
    int wgid = (int)L; { const int q = nwg / NXCD, r = nwg % NXCD, xcd = wgid % NXCD, off = wgid / NXCD; wgid = (xcd < r ? xcd * (q + 1) : r * (q + 1) + (xcd - r) * q) + off; }
    const int nig = WGM * nN, gid = wgid / nig, fm = gid * WGM, gsz = (nM - fm) < WGM ? (nM - fm) : WGM;
    pm = fm + ((wgid % nig) % gsz); pn = (wgid % nig) / gsz; return true;
}
template <int MODE> struct Sched {
    static constexpr bool GATHER = (MODE == 2); static constexpr int MODE_ = MODE;
    const char* A; const char* Bt; int K; unsigned a_rs, b_rs;
    int nM, nN, G, c;
    const int* tokl; size_t b_estride;
    const LAS int* mt;
    __device__ __forceinline__ bool next(int i, Unit& u) const {
        int pm, pn; const int nm = (MODE >= 2) ? __builtin_amdgcn_readfirstlane(mt[8]) : nM;
        if (!static_unit(i, G, c, nm, nN, pm, pn)) return false;
        u.pm = pm; u.pn = pn; u.e = 0; u.rows = 256;
        if (MODE >= 2) { const int e = __builtin_amdgcn_readfirstlane(mt[32 + pm]); const int ts = __builtin_amdgcn_readfirstlane(mt[9 + e]); const int cn = __builtin_amdgcn_readfirstlane(mt[e]);
            u.e = e; const int j = pm - ts; const int rem = cn - 256 * j; u.rows = rem < 256 ? rem : 256; u.pm = pm; u.pn = pn; u.e = e | (j << 8); }
        return true; }
    __device__ __forceinline__ const char* a_base(const Unit& u) const { if (MODE == 2) return A; return A + (size_t)u.pm * 256 * a_rs * 2; }
    __device__ __forceinline__ const char* b_base(const Unit& u) const {
        if (MODE == 1) return Bt + (size_t)(2 * u.pn) * b_rs * 2;
        if (MODE >= 2) return Bt + (size_t)(u.e & 255) * b_estride + (size_t)u.pn * 256 * b_rs * 2;
        return Bt + (size_t)u.pn * 256 * b_rs * 2; }
    __device__ __forceinline__ unsigned b_off(int R, int C) const { if (MODE == 1) return (unsigned)((128 * R * b_rs + C) * 2u); return (unsigned)((R * b_rs + C) * 2u); }
    __device__ __forceinline__ size_t b_hstep() const { return MODE == 1 ? (size_t)b_rs * 2 : (size_t)128 * b_rs * 2; }
    __device__ __forceinline__ size_t a_hstep() const { return GATHER ? 0 : (size_t)128 * a_rs * 2; }
    __device__ __forceinline__ void a_offsets(const Unit& u, int tid, unsigned (&v)[2][2]) const {
        int R[2], C[2];
#pragma unroll
        for (int i = 0; i < 2; ++i) stage_rc(tid * 16 + i * 8192, R[i], C[i]);
#pragma unroll
        for (int h = 0; h < 2; ++h)
#pragma unroll
            for (int i = 0; i < 2; ++i) {
                if (MODE == 2) { const int e = u.e & 255, j = u.e >> 8; int slot = 256 * j + 128 * h + R[i]; const int cn = mt[e]; if (slot >= cn) slot = 0; const int t = tokl[e * CAP + slot]; v[h][i] = (unsigned)((t * a_rs + C[i]) * 2u); }
                else v[h][i] = (unsigned)((R[i] * a_rs + C[i]) * 2u); } }
};

typedef __amdgpu_buffer_rsrc_t rsrc_raw_t;
struct rsrc_t { rsrc_raw_t r; const char* p; };
template <bool USE_BUF> __device__ __forceinline__ rsrc_t mk_rsrc(const char* p) { rsrc_t o; o.p = p; if constexpr (!USE_BUF) { o.r = rsrc_raw_t(); return o; }
    const unsigned long long v = (unsigned long long)p; const unsigned lo = __builtin_amdgcn_readfirstlane((unsigned)v), hi = __builtin_amdgcn_readfirstlane((unsigned)(v >> 32));
    o.r = __builtin_amdgcn_make_buffer_rsrc((void*)(((unsigned long long)hi << 32) | lo), 0, 0xFFFFFFFF, 0x00020000); return o;
}
template <class Epi, class SchedT>
__device__ __forceinline__ void gemm_phase(LAS unsigned char* lds, const SchedT& S, const Epi& E, int wv) {
    int wvo = wv; asm volatile("" : "+s"(wvo));
    const int wid = wvo, wr = wid >> 2, wc = wid & 3;
#define PG8_TID() (TID_OF(wvo))
    const int tid = PG8_TID(); const int fr = tid & 15, fq = (tid >> 4) & 3;
    constexpr bool USE_BUF = true;
    const int K = S.K, nt = K / BK;
    unsigned vB[2], vA[2][2];
#pragma unroll
    for (int i = 0; i < 2; ++i) { int Rr, Cc; stage_rc(tid * 16 + i * 8192, Rr, Cc); const int Rb = Epi::PERM ? ((Rr & ~31) + perm32(Rr & 31)) : Rr;
        vB[i] = S.b_off(Rb, Cc); }
    const unsigned hA = (unsigned)S.a_hstep(), hB = (unsigned)S.b_hstep();
    const unsigned kstep = (unsigned)(BK * 2);
    const unsigned ldsw = (unsigned)wid * 1024u;
    const int aoff = lds_byte(wr * 64 + fr, fq * 8), boff = lds_byte(wc * 32 + fr, fq * 8);
#define PG8_SA(b, h) (((b) * 2 + (h)) * HTB)
#define PG8_SB(b, h) ((4 + (b) * 2 + (h)) * HTB)
#define PG8_STAGE(bufoff, rs, soff, voff) do { _Pragma("unroll") for (int _i = 0; _i < 2; ++_i) { \
        if constexpr (USE_BUF) __builtin_amdgcn_raw_ptr_buffer_load_lds(rs.r, (LAS void*)(lds + (bufoff) + ldsw + _i * 8192), 16, (voff)[_i], (soff), 0, 0); \
        else __builtin_amdgcn_global_load_lds((const unsigned*)(rs.p + (soff) + (voff)[_i]), (LAS unsigned*)(lds + (bufoff) + ldsw + _i * 8192), 16, 0, 0); } } while (0)
#define PG8_LDA(dst, b, h) do { if constexpr (Epi::FP8) { _Pragma("unroll") for (int m = 0; m < 4; ++m) { const i32x4 lo_ = *(const LAS i32x4*)(lds + PG8_SA(b, h) + aoff + m * 2048), hi_ = *(const LAS i32x4*)(lds + PG8_SA(b, h) + aoff + m * 2048 + 1024); \
            A8[m] = __builtin_shufflevector(lo_, hi_, 0, 1, 2, 3, 4, 5, 6, 7); } } \
        else { _Pragma("unroll") for (int m = 0; m < 4; ++m) _Pragma("unroll") for (int k = 0; k < 2; ++k) dst[m][k] = *(const LAS bf16x8*)(lds + PG8_SA(b, h) + aoff + m * 2048 + k * 1024); } } while (0)
#define PG8_LDB(dst, dst8, b, h) do { if constexpr (Epi::FP8) { _Pragma("unroll") for (int n = 0; n < 2; ++n) { const i32x4 lo_ = *(const LAS i32x4*)(lds + PG8_SB(b, h) + boff + n * 2048), hi_ = *(const LAS i32x4*)(lds + PG8_SB(b, h) + boff + n * 2048 + 1024); \
            dst8[n] = __builtin_shufflevector(lo_, hi_, 0, 1, 2, 3, 4, 5, 6, 7); } } \
        else { _Pragma("unroll") for (int n = 0; n < 2; ++n) _Pragma("unroll") for (int k = 0; k < 2; ++k) dst[n][k] = *(const LAS bf16x8*)(lds + PG8_SB(b, h) + boff + n * 2048 + k * 1024); } } while (0)
#define PG8_MMA(ai, bj, At, Bt, Bt8) do { __builtin_amdgcn_s_setprio(1); \
    if constexpr (Epi::FP8) { _Pragma("unroll") for (int m = 0; m < 4; ++m) _Pragma("unroll") for (int n = 0; n < 2; ++n) \
        acc[ai][bj][m][n] = __builtin_amdgcn_mfma_scale_f32_16x16x128_f8f6f4(Bt8[n], A8[m], acc[ai][bj][m][n], 0, 0, 0, 0x7F7F7F7F, 0, 0x7F7F7F7F); } \
    else { _Pragma("unroll") for (int m = 0; m < 4; ++m) _Pragma("unroll") for (int n = 0; n < 2; ++n) _Pragma("unroll") for (int k = 0; k < 2; ++k) \
        acc[ai][bj][m][n] = Epi::SWAP ? __builtin_amdgcn_mfma_f32_16x16x32_bf16(At[m][k], Bt[n][k], acc[ai][bj][m][n], 0, 0, 0) : __builtin_amdgcn_mfma_f32_16x16x32_bf16(Bt[n][k], At[m][k], acc[ai][bj][m][n], 0, 0, 0); } \
    __builtin_amdgcn_s_setprio(0); } while (0)
#define PG8_WAIT_V(n) asm volatile("s_waitcnt vmcnt(" #n ")" ::: "memory")
#define PG8_WAIT_L(n) asm volatile("s_waitcnt lgkmcnt(" #n ")" ::: "memory")
#define PG8_BAR __builtin_amdgcn_s_barrier()
#define PG8_SCHED __builtin_amdgcn_sched_barrier(0)
    Unit cur, nxt; int ui = 0;
    if (!S.next(0, cur)) return;
    f32x4 acc[2][2][4][2];
    { const float zi = zero_f_();
#pragma unroll
    for (int a = 0; a < 2; ++a)
#pragma unroll
        for (int b = 0; b < 2; ++b)
#pragma unroll
            for (int m = 0; m < 4; ++m)
#pragma unroll
                for (int n = 0; n < 2; ++n) acc[a][b][m][n] = (f32x4){zi, zi, zi, zi}; }
    bf16x8 At[4][2], B0[2][2], B1[2][2]; v8i32 A8[4], B80[2], B81[2];
    rsrc_t rA = mk_rsrc<USE_BUF>(S.a_base(cur)), rB = mk_rsrc<USE_BUF>(S.b_base(cur));
    S.a_offsets(cur, PG8_TID(), vA);
#define PG8_SLOT() (*(LAS u32x4*)(lds + L_SL2 + PG8_TID() * 16))
#define PG8_SLOTC() (*(LAS u32x4*)(lds + L_SS + PG8_TID() * 16))
    auto agofs = [&](int h, bool nx, unsigned (&o)[2]) { if constexpr (SchedT::GATHER) { const u32x2 t_ = *(const LAS u32x2*)(lds + (nx ? L_SL2 : L_SS) + PG8_TID() * 16 + h * 8); o[0] = t_.x; o[1] = t_.y; } else { o[0] = vA[h][0]; o[1] = vA[h][1]; } };
    if constexpr (SchedT::GATHER) PG8_SLOTC() = (u32x4){vA[0][0], vA[0][1], vA[1][0], vA[1][1]};
    if constexpr (SchedT::GATHER) { Unit n1; if (S.next(1, n1)) { unsigned vn[2][2]; S.a_offsets(n1, PG8_TID(), vn); PG8_SLOT() = (u32x4){vn[0][0], vn[0][1], vn[1][0], vn[1][1]}; } }
    PG8_STAGE(PG8_SB(0, 0), rB, 0u, vB); PG8_STAGE(PG8_SB(0, 1), rB, hB, vB); { unsigned o0[2], o1[2]; agofs(0, false, o0); agofs(1, false, o1); PG8_STAGE(PG8_SA(0, 0), rA, 0u, o0); PG8_STAGE(PG8_SA(0, 1), rA, hA, o1); }
    if (wr == 1) PG8_BAR;
    PG8_WAIT_V(2); PG8_BAR;
    PG8_STAGE(PG8_SB(1, 0), rB, kstep, vB); { unsigned o0[2]; agofs(0, false, o0); PG8_STAGE(PG8_SA(1, 0), rA, kstep, o0); } PG8_STAGE(PG8_SB(1, 1), rB, kstep + hB, vB);
    PG8_WAIT_V(6); PG8_BAR;
    for (;;) {
        const bool has_next = S.next(ui + 1, nxt);
        const rsrc_t rAn = has_next ? mk_rsrc<USE_BUF>(S.a_base(nxt)) : rA; const rsrc_t rBn = has_next ? mk_rsrc<USE_BUF>(S.b_base(nxt)) : rB;
#pragma unroll 1
        for (int t = 0; t < nt; t += 2) {
            const bool last = (t == nt - 2);
            const unsigned s1 = (unsigned)(t + 1) * kstep;
            const rsrc_t rA2 = last ? rAn : rA; const rsrc_t rB2 = last ? rBn : rB;
            const unsigned s2 = last ? 0u : (unsigned)(t + 2) * kstep; const unsigned s3 = s2 + kstep;
            const bool nx = last && has_next;
            if constexpr (Epi::HOOK) { if (t == Epi::H1 || t == Epi::H2) { const int t_h = PG8_TID(); E.mid(acc, cur, t, wr, wc, t_h & 15, (t_h >> 4) & 3); } }
            PG8_LDB(B0, B80, 0, 0); PG8_LDB(B1, B81, 0, 1); PG8_SCHED; PG8_LDA(At, 0, 0); { unsigned o_[2]; agofs(1, false, o_); PG8_STAGE(PG8_SA(1, 1), rA, s1 + hA, o_); }
            PG8_WAIT_V(8); PG8_WAIT_L(0); PG8_BAR; PG8_MMA(0, 0, At, B0, B80); PG8_MMA(0, 1, At, B1, B81); PG8_BAR; PG8_SCHED;
            PG8_LDA(At, 0, 1); PG8_STAGE(PG8_SB(0, 0), rB2, s2, vB); PG8_STAGE(PG8_SB(0, 1), rB2, s2 + hB, vB); { unsigned o_[2]; agofs(0, nx, o_); PG8_STAGE(PG8_SA(0, 0), rA2, s2, o_); }
            PG8_WAIT_V(8); PG8_WAIT_L(0); PG8_BAR; PG8_MMA(1, 0, At, B0, B80); PG8_MMA(1, 1, At, B1, B81); PG8_BAR; PG8_SCHED;
            PG8_LDB(B0, B80, 1, 0); PG8_LDB(B1, B81, 1, 1); PG8_SCHED; PG8_LDA(At, 1, 0); { unsigned o_[2]; agofs(1, nx, o_); PG8_STAGE(PG8_SA(0, 1), rA2, s2 + hA, o_); }
            PG8_WAIT_V(8); PG8_WAIT_L(0); PG8_BAR; PG8_MMA(0, 0, At, B0, B80); PG8_MMA(0, 1, At, B1, B81); PG8_BAR; PG8_SCHED;
            PG8_LDA(At, 1, 1); PG8_STAGE(PG8_SB(1, 0), rB2, s3, vB); PG8_STAGE(PG8_SB(1, 1), rB2, s3 + hB, vB); { unsigned o_[2]; agofs(0, nx, o_); PG8_STAGE(PG8_SA(1, 0), rA2, s3, o_); }
            PG8_WAIT_V(8); PG8_WAIT_L(0); PG8_BAR; PG8_MMA(1, 0, At, B0, B80); PG8_MMA(1, 1, At, B1, B81); PG8_BAR; PG8_SCHED;
        }
        unsigned vn2[2][2] = {{0u, 0u}, {0u, 0u}}; bool has_n2 = false;
        if constexpr (SchedT::GATHER) { Unit n2; has_n2 = has_next && S.next(ui + 2, n2); if (has_n2) S.a_offsets(n2, PG8_TID(), vn2); }
        if (wr == 0) PG8_BAR;
        { const int tid_e = PG8_TID();
          E(acc, cur, wr, wc, tid_e & 15, (tid_e >> 4) & 3, lds + RING_BYTES, tid_e); }
        if (!has_next) break;
        { const float z0 = zero_f_();
#pragma unroll
        for (int a = 0; a < 2; ++a)
#pragma unroll
            for (int b = 0; b < 2; ++b)
#pragma unroll
                for (int m = 0; m < 4; ++m)
#pragma unroll
                    for (int n = 0; n < 2; ++n) acc[a][b][m][n] = (f32x4){z0, z0, z0, z0}; }
        if constexpr (SchedT::MODE_ == 0) nxt.e = (nxt.pm == cur.pm) ? 1 : 0;
        cur = nxt; rA = rAn; rB = rBn; ++ui;
        if constexpr (SchedT::GATHER) { const u32x4 o = PG8_SLOT(); PG8_SLOTC() = o;
            if (has_n2) PG8_SLOT() = (u32x4){vn2[0][0], vn2[0][1], vn2[1][0], vn2[1][1]}; }
        if (wr == 1) PG8_BAR;
    }
    PG8_WAIT_V(0);
    PG8_BAR;
#undef PG8_SA
#undef PG8_SB
#undef PG8_STAGE
#undef PG8_LDA
#undef PG8_LDB
#undef PG8_MMA
#undef PG8_SLOT
#undef PG8_SLOTC
#undef PG8_TID
}
#define EPI_BAR() do { asm volatile("s_waitcnt lgkmcnt(0)" ::: "memory"); __builtin_amdgcn_s_barrier(); asm volatile("" ::: "memory"); } while (0)

template <int PERMTOK> __device__ __forceinline__ void finalize_rs(const float* xss, int base, LAS unsigned char* ext, int tid) {
    const int j = tid >> 1, hf = tid & 1; int tok;
    if (PERMTOK) { const int n = base + j; tok = 128 * (n & 127) + (n >> 7); } else tok = base + j;
    const f32x4* p = (const f32x4*)(xss + (size_t)tok * 32 + hf * 16); const f32x4 a = p[0], b = p[1], c = p[2], d = p[3];
    float s = ((a[0] + a[1]) + (a[2] + a[3])) + ((b[0] + b[1]) + (b[2] + b[3])) + ((c[0] + c[1]) + (c[2] + c[3])) + ((d[0] + d[1]) + (d[2] + d[3]));
    s += shflx(s, 1);
    if (hf == 0) ((LAS float*)(ext + (L_RS - RING_BYTES)))[j] = 1.f / sqrtf(s * (1.f / D) + EPS);
    EPI_BAR();
}
#define ACC_T const f32x4 (&acc)[2][2][4][2]

template <bool F8> struct EpInMain { static constexpr bool PERM = true, SWAP = false, HOOK = false, FP8 = F8; static constexpr int H1 = -1, H2 = -1;
    const float* xss; bf16 *qn, *kn, *qm; const float *qg, *kg, *mqg;
    __device__ __forceinline__ void operator()(ACC_T, const Unit& u, int wr, int wc, int fr, int fq, LAS unsigned char* ext, int tidx) const {
        if (!u.e) finalize_rs<0>(xss, u.pm * 256, ext, tidx);
        const LAS float* Trs = (const LAS float*)(ext + (L_RS - RING_BYTES)); LAS float* Tss = (LAS float*)(ext + (L_SS - RING_BYTES));
        const int pn = u.pn; const int lrow0 = wr * 64 + fr; const size_t grow0 = (size_t)u.pm * 256 + lrow0;
        bf16* dst; int ld, colt; const float* g; float sc;
        if (pn < 4) { dst = qn; ld = 1024; colt = pn * 256; g = qg; sc = QSCALE; } else if (pn < 8) { dst = kn; ld = 1024; colt = (pn - 4) * 256; g = kg; sc = 1.f; } else { dst = qm; ld = 512; colt = (pn - 8) * 256; g = mqg; sc = QSCALE; }
#pragma unroll
        for (int ai = 0; ai < 2; ++ai)
#pragma unroll
            for (int m = 0; m < 4; ++m) { const float rs = Trs[lrow0 + ai * 128 + m * 16] * (F8 ? (1.f / 64.f) : 1.f);
#pragma unroll
                for (int bj = 0; bj < 2; ++bj) { const f32x4 v0 = acc[ai][bj][m][0] * rs, v1 = acc[ai][bj][m][1] * rs;
                    float s = (v0[0] * v0[0] + v0[1] * v0[1]) + (v0[2] * v0[2] + v0[3] * v0[3]) + (v1[0] * v1[0] + v1[1] * v1[1]) + (v1[2] * v1[2] + v1[3] * v1[3]);
                    s += shflx(s, 16); s += shflx(s, 32);
                    if (fq == 0) Tss[((lrow0 + ai * 128 + m * 16) * 2 + bj) * 4 + wc] = s; } }
        EPI_BAR();
        const f32x4 g0 = *(const f32x4*)(g + wc * 32 + 8 * fq), g1 = *(const f32x4*)(g + wc * 32 + 8 * fq + 4);
#pragma unroll
        for (int ai = 0; ai < 2; ++ai)
#pragma unroll
            for (int m = 0; m < 4; ++m) { const float rs = Trs[lrow0 + ai * 128 + m * 16] * (F8 ? (1.f / 64.f) : 1.f); bf16* rowp = dst + (grow0 + ai * 128 + m * 16) * ld + colt + wc * 32 + 8 * fq;
#pragma unroll
                for (int bj = 0; bj < 2; ++bj) { const f32x4 ss4 = *(const LAS f32x4*)(Tss + ((lrow0 + ai * 128 + m * 16) * 2 + bj) * 4); const float tot = (ss4[0] + ss4[1]) + (ss4[2] + ss4[3]);
                    const float rn = rs * sc * __builtin_amdgcn_rsqf(tot * (1.f / HD) + EPS); const f32x4 v0 = acc[ai][bj][m][0] * rn * g0, v1 = acc[ai][bj][m][1] * rn * g1; u32x4 w;
                    w.x = cvt_pk_bf16(v0[0], v0[1]); w.y = cvt_pk_bf16(v0[2], v0[3]); w.z = cvt_pk_bf16(v1[0], v1[1]); w.w = cvt_pk_bf16(v1[2], v1[3]);
                    if (pn >= 4 && pn < 8) {
                        const int tok = (int)(grow0 + ai * 128 + m * 16); const int hd = 2 * (pn - 4) + bj, T = tok >> 5, rr = prow32(tok & 31), s_ = 2 * wc + (fq >> 1), h_ = fq & 1;
                        *(u32x4*)(kn + ((((size_t)(hd * 512 + T) * 8 + s_) * 64) + h_ * 32 + rr) * 8) = w; }
                    else *(u32x4*)(rowp + bj * 128) = w; }
                asm volatile("" ::: "memory"); }
    } };
struct EpGates8 { static constexpr bool PERM = true, SWAP = false, HOOK = false, FP8 = true; static constexpr int H1 = -1, H2 = -1;
    const float* xss; unsigned char* gt;
    static __device__ __forceinline__ unsigned q8(float z) { const float t = 255.f * sigmoidf_(z); return (unsigned)__builtin_rintf(__builtin_fmaxf(t, 1.f)); }
    static __device__ __forceinline__ unsigned q8s(float sg) { return (unsigned)__builtin_rintf(__builtin_fmaxf(255.f * sg, 1.f)); }
    static __device__ __forceinline__ unsigned q8x4(const f32x4 a, float rsn) { f32x4 t;
#pragma unroll
        for (int q = 0; q < 4; ++q) t[q] = __builtin_amdgcn_exp2f(a[q] * rsn);
#pragma unroll
        for (int q = 0; q < 4; ++q) t[q] = __builtin_fmaf(t[q], 1.f / 255.f, 1.f / 255.f);
#pragma unroll
        for (int q = 0; q < 4; ++q) t[q] = __builtin_fmaxf(__builtin_amdgcn_rcpf(t[q]), 1.f);
        return (unsigned)__builtin_rintf(t[0]) | ((unsigned)__builtin_rintf(t[1]) << 8) | ((unsigned)__builtin_rintf(t[2]) << 16) | ((unsigned)__builtin_rintf(t[3]) << 24); }
    __device__ __forceinline__ void operator()(ACC_T, const Unit& u, int wr, int wc, int fr, int fq, LAS unsigned char* ext, int tidx) const {
        if (!u.e) finalize_rs<0>(xss, u.pm * 256, ext, tidx);
        const LAS float* Trs = (const LAS float*)(ext + (L_RS - RING_BYTES));
        const int lrow0 = wr * 64 + fr; const size_t grow0 = (size_t)u.pm * 256 + lrow0; const int col = u.pn * 256 + wc * 32 + 8 * fq;
#pragma unroll
        for (int ai = 0; ai < 2; ++ai)
#pragma unroll
            for (int m = 0; m < 4; ++m) { const float rsn = Trs[lrow0 + ai * 128 + m * 16] * (-1.4426950408889634f / 64.f); unsigned char* rowp = gt + (grow0 + ai * 128 + m * 16) * 6144 + col;
#pragma unroll
                for (int bj = 0; bj < 2; ++bj) { u32x2 w; w.x = q8x4(acc[ai][bj][m][0], rsn); w.y = q8x4(acc[ai][bj][m][1], rsn);
                    *(u32x2*)(rowp + bj * 128) = w; }
                asm volatile("" ::: "memory"); }
    } };
template <int PERMTOK, bool F8 = false> struct EpT { static constexpr bool PERM = true, SWAP = false, HOOK = false, FP8 = F8; static constexpr int H1 = -1, H2 = -1;
    const float* xss; bf16* dst;
    __device__ __forceinline__ void operator()(ACC_T, const Unit& u, int wr, int wc, int fr, int fq, LAS unsigned char* ext, int tidx) const {
        finalize_rs<PERMTOK>(xss, u.pn * 256, ext, tidx);
        const LAS float* Trs = (const LAS float*)(ext + (L_RS - RING_BYTES));
        f32x4 r0[2], r1[2];
#pragma unroll
        for (int bj = 0; bj < 2; ++bj) { r0[bj] = *(const LAS f32x4*)(Trs + bj * 128 + wc * 32 + 8 * fq); r1[bj] = *(const LAS f32x4*)(Trs + bj * 128 + wc * 32 + 8 * fq + 4); if (F8) { r0[bj] = r0[bj] * (1.f / 64.f); r1[bj] = r1[bj] * (1.f / 64.f); } }
        const size_t grow0 = (size_t)u.pm * 256 + wr * 64 + fr; const int col = u.pn * 256 + wc * 32 + 8 * fq;
#pragma unroll
        for (int ai = 0; ai < 2; ++ai)
#pragma unroll
            for (int m = 0; m < 4; ++m) { bf16* rowp = dst + (grow0 + ai * 128 + m * 16) * S + col;
#pragma unroll
                for (int bj = 0; bj < 2; ++bj) { const f32x4 v0 = acc[ai][bj][m][0] * r0[bj], v1 = acc[ai][bj][m][1] * r1[bj]; u32x4 w;
                    w.x = cvt_pk_bf16(v0[0], v0[1]); w.y = cvt_pk_bf16(v0[2], v0[3]); w.z = cvt_pk_bf16(v1[0], v1[1]); w.w = cvt_pk_bf16(v1[2], v1[3]);
                    if (PERMTOK == 0) {
                        const int f = (int)(grow0 + ai * 128 + m * 16); const int hd = f >> 7, dd = f & 127, T = 8 * u.pn + 4 * bj + wc;
                        *(u32x4*)(dst + (((((size_t)(hd * 512 + T) * 4 + (dd >> 5)) * 2 + (fq >> 1)) * 64) + (fq & 1) * 32 + (dd & 31)) * 8) = w; }
                    else *(u32x4*)(rowp + bj * 128) = w; } }
    } };
__device__ __forceinline__ f32x4 bf4_to_f32(u32x2 g) { return (f32x4){bf2f(g.x & 0xffff), bf2f(g.x >> 16), bf2f(g.y & 0xffff), bf2f(g.y >> 16)}; }
template <bool MG8> struct EpMerge { static constexpr bool PERM = true, SWAP = false, HOOK = true, FP8 = false; static constexpr int H1 = 16, H2 = 24;
    const unsigned char* gt; bf16* mg;
    static __device__ __forceinline__ f32x4 ub4(unsigned w) { return (f32x4){(float)(w & 0xffu), (float)((w >> 8) & 0xffu), (float)((w >> 16) & 0xffu), (float)(w >> 24)}; }
    __device__ __forceinline__ void mid(f32x4 (&acc)[2][2][4][2], const Unit& u, int t, int wr, int wc, int fr, int fq) const {
        const int gnum = (t == H1) ? 2048 : 4096, gden = (t == H1) ? 4096 : 0;
        const size_t grow0 = (size_t)u.pm * 256 + wr * 64 + fr; const int col0 = u.pn * 256 + wc * 32 + 8 * fq;
#pragma unroll
        for (int ai = 0; ai < 2; ++ai) {
            u32x2 av[4][2], dv[4][2];
#pragma unroll
            for (int m = 0; m < 4; ++m) { const unsigned char* gp = gt + (grow0 + ai * 128 + m * 16) * 6144 + col0;
#pragma unroll
                for (int bj = 0; bj < 2; ++bj) { av[m][bj] = *(const u32x2*)(gp + gnum + bj * 128); dv[m][bj] = *(const u32x2*)(gp + gden + bj * 128); } }
            asm volatile("" : "+v"(av[0][0]), "+v"(av[0][1]), "+v"(av[1][0]), "+v"(av[1][1]), "+v"(av[2][0]), "+v"(av[2][1]), "+v"(av[3][0]), "+v"(av[3][1]),
                              "+v"(dv[0][0]), "+v"(dv[0][1]), "+v"(dv[1][0]), "+v"(dv[1][1]), "+v"(dv[2][0]), "+v"(dv[2][1]), "+v"(dv[3][0]), "+v"(dv[3][1]));
#pragma unroll
            for (int m = 0; m < 4; ++m) {
#pragma unroll
                for (int bj = 0; bj < 2; ++bj) { const u32x2 a = av[m][bj], d = dv[m][bj];
                    const f32x4 a0 = ub4(a.x), a1 = ub4(a.y), d0 = ub4(d.x), d1 = ub4(d.y);
#pragma unroll
                    for (int q = 0; q < 4; ++q) { acc[ai][bj][m][0][q] *= a0[q] * __builtin_amdgcn_rcpf(d0[q]); acc[ai][bj][m][1][q] *= a1[q] * __builtin_amdgcn_rcpf(d1[q]); } } }
            asm volatile("" ::: "memory"); }
    }
    __device__ __forceinline__ void operator()(ACC_T, const Unit& u, int wr, int wc, int fr, int fq, LAS unsigned char*, int) const {
        const size_t grow0 = (size_t)u.pm * 256 + wr * 64 + fr; const int col0 = u.pn * 256 + wc * 32 + 8 * fq;
#pragma unroll
        for (int ai = 0; ai < 2; ++ai) {
            u32x2 gv[4][2];
#pragma unroll
            for (int m = 0; m < 4; ++m)
#pragma unroll
                for (int bj = 0; bj < 2; ++bj) gv[m][bj] = *(const u32x2*)(gt + (grow0 + ai * 128 + m * 16) * 6144 + col0 + bj * 128);
            asm volatile("" : "+v"(gv[0][0]), "+v"(gv[0][1]), "+v"(gv[1][0]), "+v"(gv[1][1]), "+v"(gv[2][0]), "+v"(gv[2][1]), "+v"(gv[3][0]), "+v"(gv[3][1]));
#pragma unroll
            for (int m = 0; m < 4; ++m) { const size_t row = grow0 + ai * 128 + m * 16;
#pragma unroll
                for (int bj = 0; bj < 2; ++bj) { const int c = col0 + bj * 128; const u32x2 g = gv[m][bj];
                    const f32x4 o0 = ub4(g.x) * acc[ai][bj][m][0] * ((MG8 ? 16.f : 1.f) / 255.f), o1 = ub4(g.y) * acc[ai][bj][m][1] * ((MG8 ? 16.f : 1.f) / 255.f);
                    if (MG8) { int w0 = zero_i_(), w1 = zero_i_(); w0 = __builtin_amdgcn_cvt_pk_fp8_f32(o0[0], o0[1], w0, false); w0 = __builtin_amdgcn_cvt_pk_fp8_f32(o0[2], o0[3], w0, true);
                        w1 = __builtin_amdgcn_cvt_pk_fp8_f32(o1[0], o1[1], w1, false); w1 = __builtin_amdgcn_cvt_pk_fp8_f32(o1[2], o1[3], w1, true);
                        u32x2 w; w.x = (unsigned)w0; w.y = (unsigned)w1; *(u32x2*)((unsigned char*)mg + row * D + c) = w; }
                    else { u32x4 w; w.x = cvt_pk_bf16(o0[0], o0[1]); w.y = cvt_pk_bf16(o0[2], o0[3]); w.z = cvt_pk_bf16(o1[0], o1[1]); w.w = cvt_pk_bf16(o1[2], o1[3]);
                        *(u32x4*)(mg + row * D + c) = w; } } }
            asm volatile("" ::: "memory"); }
    } };
template <int XB8, int SCI = 1> struct EpRes { static constexpr bool PERM = true, SWAP = false, HOOK = false, FP8 = (SCI != 1); static constexpr int H1 = -1, H2 = -1; static constexpr float SC = 1.f / (float)SCI;
    bf16* xb; float* xss; unsigned char* xb8;
    __device__ __forceinline__ void operator()(ACC_T, const Unit& u, int wr, int wc, int fr, int fq, LAS unsigned char*, int) const {
        const size_t grow0 = (size_t)u.pm * 256 + wr * 64 + fr; const int col0 = u.pn * 256 + wc * 32 + 8 * fq;
#pragma unroll
        for (int ai = 0; ai < 2; ++ai) {
            u32x4 oldv[4][2];
#pragma unroll
            for (int m = 0; m < 4; ++m)
#pragma unroll
                for (int bj = 0; bj < 2; ++bj) oldv[m][bj] = *(const u32x4*)(xb + (grow0 + ai * 128 + m * 16) * D + col0 + bj * 128);
            asm volatile("" : "+v"(oldv[0][0]), "+v"(oldv[0][1]), "+v"(oldv[1][0]), "+v"(oldv[1][1]), "+v"(oldv[2][0]), "+v"(oldv[2][1]), "+v"(oldv[3][0]), "+v"(oldv[3][1]));
#pragma unroll
            for (int m = 0; m < 4; ++m) { const size_t row = grow0 + ai * 128 + m * 16; float ss = 0.f;
#pragma unroll
                for (int bj = 0; bj < 2; ++bj) { const int c = col0 + bj * 128; const u32x4 old = oldv[m][bj];
                    const f32x4 o0 = bf4_to_f32((u32x2){old.x, old.y}) + acc[ai][bj][m][0] * SC, o1 = bf4_to_f32((u32x2){old.z, old.w}) + acc[ai][bj][m][1] * SC; u32x4 w;
                    w.x = cvt_pk_bf16(o0[0], o0[1]); w.y = cvt_pk_bf16(o0[2], o0[3]); w.z = cvt_pk_bf16(o1[0], o1[1]); w.w = cvt_pk_bf16(o1[2], o1[3]); *(u32x4*)(xb + row * D + c) = w;
                    if (XB8 != 0) { int w0 = zero_i_(), w1 = zero_i_(); w0 = __builtin_amdgcn_cvt_pk_fp8_f32(o0[0], o0[1], w0, false); w0 = __builtin_amdgcn_cvt_pk_fp8_f32(o0[2], o0[3], w0, true);
                        w1 = __builtin_amdgcn_cvt_pk_fp8_f32(o1[0], o1[1], w1, false); w1 = __builtin_amdgcn_cvt_pk_fp8_f32(o1[2], o1[3], w1, true); u32x2 w8; w8.x = (unsigned)w0; w8.y = (unsigned)w1; *(u32x2*)(xb8 + row * D + c) = w8; }
                    ss += ((o0[0] * o0[0] + o0[1] * o0[1]) + (o0[2] * o0[2] + o0[3] * o0[3])) + ((o1[0] * o1[0] + o1[1] * o1[1]) + (o1[2] * o1[2] + o1[3] * o1[3])); }
                if (xss) { ss += shflx(ss, 16); ss += shflx(ss, 32); if (fq == 0) xss[row * 32 + u.pn * 4 + wc] = ss; } } }
    } };
template <int MOE> struct EpGU { static constexpr bool PERM = true, SWAP = false, HOOK = false, FP8 = false; static constexpr int H1 = -1, H2 = -1;
    const float* xss; const float* rstok; const int* tokl; bf16* hm; const LAS int* mt;
    __device__ __forceinline__ void operator()(ACC_T, const Unit& u, int wr, int wc, int fr, int fq, LAS unsigned char* ext, int tidx) const {
        const int lrow0 = wr * 64 + fr; const int col = u.pn * 128 + wc * 16 + 4 * fq;
        const LAS float* Trs = (const LAS float*)(ext + (L_RS - RING_BYTES));
        if (!MOE && !u.e) finalize_rs<0>(xss, u.pm * 256, ext, tidx);
        const int e = u.e & 255, j = u.e >> 8; const int cn = MOE ? mt[e] : 0;
#pragma unroll
        for (int ai = 0; ai < 2; ++ai)
#pragma unroll
            for (int m = 0; m < 4; ++m) { const int lr = lrow0 + ai * 128 + m * 16; float rs;
                if (MOE) { int slot = 256 * j + lr; if (slot >= cn) slot = 0; rs = rstok[tokl[e * CAP + slot]]; } else rs = Trs[lr];
                bf16* rowp = hm + ((size_t)u.pm * 256 + lr) * DFF + col;
#pragma unroll
                for (int bj = 0; bj < 2; ++bj) { const f32x4 gq = acc[ai][bj][m][0] * rs, uq = acc[ai][bj][m][1] * rs; const f32x4 sg = sigmoid4_(gq); f32x4 o;
#pragma unroll
                    for (int q = 0; q < 4; ++q) o[q] = gq[q] * sg[q] * uq[q];
                    u32x2 w; w.x = cvt_pk_bf16(o[0], o[1]); w.y = cvt_pk_bf16(o[2], o[3]); *(u32x2*)(rowp + bj * 64) = w; }
                asm volatile("" ::: "memory"); }
    } };
struct EpGU8 { static constexpr bool PERM = true, SWAP = false, HOOK = false, FP8 = true; static constexpr int H1 = -1, H2 = -1;
    const float* rstok; const int* tokl; unsigned char* hm; const LAS int* mt;
    __device__ __forceinline__ void operator()(ACC_T, const Unit& u, int wr, int wc, int fr, int fq, LAS unsigned char*, int) const {
        const int lrow0 = wr * 64 + fr; const int col = u.pn * 128 + wc * 16 + 4 * fq; const int e = u.e & 255, j = u.e >> 8; const int cn = mt[e];
        float rsv[2][4];
#pragma unroll
        for (int ai = 0; ai < 2; ++ai)
#pragma unroll
            for (int m = 0; m < 4; ++m) { int slot = 256 * j + lrow0 + ai * 128 + m * 16; if (slot >= cn) slot = 0; rsv[ai][m] = rstok[e * CAP + slot]; }
        asm volatile("" : "+v"(rsv[0][0]), "+v"(rsv[0][1]), "+v"(rsv[0][2]), "+v"(rsv[0][3]), "+v"(rsv[1][0]), "+v"(rsv[1][1]), "+v"(rsv[1][2]), "+v"(rsv[1][3]));
#pragma unroll
        for (int ai = 0; ai < 2; ++ai)
#pragma unroll
            for (int m = 0; m < 4; ++m) { const int lr = lrow0 + ai * 128 + m * 16; const float rs = rsv[ai][m] * (1.f / 64.f);
                unsigned char* rowp = hm + ((size_t)u.pm * 256 + lr) * DFF + col;
#pragma unroll
                for (int bj = 0; bj < 2; ++bj) { const f32x4 gq = acc[ai][bj][m][0] * rs, uq = acc[ai][bj][m][1] * rs; const f32x4 sg = sigmoid4_(gq); f32x4 o;
#pragma unroll
                    for (int q = 0; q < 4; ++q) o[q] = 4.f * gq[q] * sg[q] * uq[q];
                    int w8 = zero_i_(); w8 = __builtin_amdgcn_cvt_pk_fp8_f32(o[0], o[1], w8, false); w8 = __builtin_amdgcn_cvt_pk_fp8_f32(o[2], o[3], w8, true); *(int*)(rowp + bj * 64) = w8; }
                asm volatile("" ::: "memory"); }
    } };
struct EpMoeY { static constexpr bool PERM = true, SWAP = false, HOOK = false, FP8 = true; static constexpr int H1 = -1, H2 = -1;
    bf16* yb;
    __device__ __forceinline__ void operator()(ACC_T, const Unit& u, int wr, int wc, int fr, int fq, LAS unsigned char*, int) const {
        const size_t grow0 = (size_t)u.pm * 256 + wr * 64 + fr; const int col0 = u.pn * 256 + wc * 32 + 8 * fq; const float sc = 1.f / 256.f;
#pragma unroll
        for (int ai = 0; ai < 2; ++ai)
#pragma unroll
            for (int m = 0; m < 4; ++m) { bf16* rowp = yb + (grow0 + ai * 128 + m * 16) * D + col0;
#pragma unroll
                for (int bj = 0; bj < 2; ++bj) { const f32x4 v0 = acc[ai][bj][m][0] * sc, v1 = acc[ai][bj][m][1] * sc; u32x4 w;
                    w.x = cvt_pk_bf16(v0[0], v0[1]); w.y = cvt_pk_bf16(v0[2], v0[3]); w.z = cvt_pk_bf16(v1[0], v1[1]); w.w = cvt_pk_bf16(v1[2], v1[3]);
                    *(u32x4*)(rowp + bj * 128) = w; } }
    } };
}

#define XB_TMO      128
#define XB_XCNT(j)  (256  + 64 * (j))
#define XB_XSUB(j)  (1280 + 64 * (j))
#define XB_XGEN(j)  (2304 + 64 * (j))
#define XB_TOP      3328
#define XB_TOPGEN   3392
#define XCD_BAR_WORDS 3456
#define XB_SPIN_CAP (1u << 18)
__device__ __forceinline__ unsigned xb_ld(unsigned* p)              { return __hip_atomic_load((GAS unsigned*)p, __ATOMIC_RELAXED, __HIP_MEMORY_SCOPE_AGENT); }
__device__ __forceinline__ unsigned xb_add(unsigned* p, unsigned v) { return __hip_atomic_fetch_add((GAS unsigned*)p, v, __ATOMIC_RELAXED, __HIP_MEMORY_SCOPE_AGENT); }
__device__ __forceinline__ unsigned xb_xcc_id() { return (unsigned)__builtin_amdgcn_s_getreg((3 << 11) | 20) & 0xFu; }
#define XB_SPIN(cond, bar) do { unsigned _sp = 0; while (cond) { __builtin_amdgcn_s_sleep(1); \
    if ((++_sp & 255u) == 0u) { if (xb_ld(&(bar)[XB_TMO])) break; if (_sp > XB_SPIN_CAP) { (void)xb_add(&(bar)[XB_TMO], 1u); break; } } } } while (0)
struct XcdBarrier { unsigned* bar; unsigned x; volatile LAS unsigned* st; int wv; };
__device__ __forceinline__ XcdBarrier xcd_barrier_post(unsigned* bar, volatile LAS unsigned* st, int wv) {
    XcdBarrier b; b.bar = bar; b.x = xb_xcc_id(); b.st = st; b.wv = wv;
    if (threadIdx.x == 0) (void)xb_add(&bar[XB_XCNT(b.x)], 1u);
    return b;
}
__device__ __forceinline__ void xcd_barrier_complete(unsigned* bar, unsigned x, unsigned& nloc, unsigned& nx) {
    const unsigned G = gridDim.x * gridDim.y * gridDim.z;
    unsigned sum, cnt, mine, sp = 0u;
    for (;;) {
        sum = 0u; cnt = 0u; mine = 0u;
#pragma unroll
        for (unsigned j = 0; j < 16; ++j) { const unsigned c = xb_ld(&bar[XB_XCNT(j)]); sum += c; cnt += (c > 0u) ? 1u : 0u; mine = (j == x) ? c : mine; }
        if (sum == G) break;
        __builtin_amdgcn_s_sleep(1);
        if ((++sp & 255u) == 0u) { if (xb_ld(&bar[XB_TMO])) break; if (sp > XB_SPIN_CAP) { (void)xb_add(&bar[XB_TMO], 1u); break; } }
    }
    nloc = mine > 0u ? mine : 1u; nx = cnt > 0u ? cnt : 1u;
}
__device__ __forceinline__ void xcd_barrier(const XcdBarrier& b) {
    asm volatile("s_waitcnt vmcnt(0)" ::: "memory");
    __syncthreads();
    if (b.wv == 0 && lane_id_() == 0) {
        unsigned* bar = b.bar; asm volatile("" : "+v"(bar));
        __builtin_amdgcn_s_waitcnt(0);
        unsigned nloc = b.st[0], nx = b.st[1];
        if (nloc == 0u) { xcd_barrier_complete(bar, b.x, nloc, nx); b.st[0] = nloc; b.st[1] = nx; }
        const unsigned old = xb_add(&bar[XB_XSUB(b.x)], 1u);
        const unsigned gen = old / nloc;
        if (old + 1u == (gen + 1u) * nloc) {
            __builtin_amdgcn_fence(__ATOMIC_RELEASE, "agent");
            asm volatile("s_waitcnt vmcnt(0)" ::: "memory");
            const unsigned og = xb_add(&bar[XB_TOP], 1u);
            const unsigned tg = og / nx;
            if (og + 1u == (tg + 1u) * nx) xb_add(&bar[XB_TOPGEN], 1u);
            else XB_SPIN(xb_ld(&bar[XB_TOPGEN]) == tg, bar);
            __builtin_amdgcn_fence(__ATOMIC_ACQUIRE, "agent");
            xb_add(&bar[XB_XGEN(b.x)], 1u);
            asm volatile("s_waitcnt vmcnt(0)" ::: "memory");
        } else {
            XB_SPIN(xb_ld(&bar[XB_XGEN(b.x)]) == gen, bar);
            __builtin_amdgcn_fence(__ATOMIC_ACQUIRE, "agent");
            asm volatile("s_waitcnt vmcnt(0)" ::: "memory");
        }
    }
    __syncthreads();
}

constexpr int CW_F1 = 128;
constexpr int CW_BAR = 4096;
struct MArgs { const void* ptr[25]; int ph_lo, ph_hi, li, pad; };
__device__ __forceinline__ const void* arg_ptr(const MArgs& a, int k) { asm volatile("" : "+s"(k)); return a.ptr[k]; }
#define AIN(k) ((const float*)(const GAS float*)arg_ptr(a, (k)))
#define AOUT ((float*)(GAS float*)arg_ptr(a, 23))
#define AWS ((unsigned char*)(GAS unsigned char*)arg_ptr(a, 24))
constexpr int NPHASE = 18;

__device__ __forceinline__ void moe_tables(LAS int* mt, const unsigned* cnt, int t) {
    if (t < 160) { int ts = 0, mye = 0;
#pragma unroll
        for (int e = 0; e < NE; ++e) { const int c = (int)cnt[e]; if (t == e) { mt[e] = c; mt[9 + e] = ts; } if (e > 0 && ts <= t) mye = e; ts += (c + 255) >> 8; }
        mt[32 + t] = mye; if (t == 8) mt[8] = ts; }
    asm volatile("s_waitcnt lgkmcnt(0)" ::: "memory"); __syncthreads();
}

__global__ void __launch_bounds__(512, 2) mega(MArgs a) {
    extern __shared__ __attribute__((aligned(16))) unsigned char lds_raw[];
    LAS unsigned char* lds = (LAS unsigned char*)lds_raw;
    const int wave_s = __builtin_amdgcn_readfirstlane(threadIdx.x >> 6);
    unsigned char* ws = AWS;
    volatile LAS unsigned* MISC = (volatile LAS unsigned*)(lds + L_MISC);
    for (int u = threadIdx.x; u < (LDS_BYTES - RING_BYTES) / 4; u += 512) ((LAS unsigned*)(lds + RING_BYTES))[u] = 0u;
    __syncthreads();
    XcdBarrier bar = xcd_barrier_post((unsigned*)(ws + OFF_CTL) + CW_BAR + a.li * XCD_BAR_WORDS, MISC + 8, wave_s);
    const int lo = a.ph_lo, hi = a.ph_hi;
#define IN(k) (lo <= (k) && (k) < hi)
#define SEAM(k) do { if (IN(k) && IN((k) + 1)) xcd_barrier(bar); } while (0)
    LAS int* mt = (LAS int*)(lds + L_MOE);

#define PHASE_BEGIN() int tid = TID_OF(wave_s); asm volatile("" : "+v"(tid)); const int lane = tid & 63; (void)lane; \
    int G = gridDim.x, bx = blockIdx.x; asm volatile("" : "+s"(G), "+s"(bx)); const int wave = wave_s; \
    const int vcu = (G % 8 == 0) ? (bx % 8) * (G / 8) + bx / 8 : bx; const int gw = vcu * 8 + wave, NGW = G * 8; (void)gw; (void)NGW; (void)vcu; \
    unsigned char* ws = AWS; unsigned* ctl = (unsigned*)(ws + OFF_CTL); (void)ctl; \
    bf16 *xb = (bf16*)(ws + OFF_XB), *qn = (bf16*)(ws + OFF_QN), *kn = (bf16*)(ws + OFF_KN), *vT = (bf16*)(ws + OFF_VT), *qm = (bf16*)(ws + OFF_QM), *gt = (bf16*)(ws + OFF_GT), *finT = (bf16*)(ws + OFF_FINT); \
    bf16 *ym = (bf16*)(ws + OFF_YM), *ona = (bf16*)(ws + OFF_ONA), *omem = (bf16*)(ws + OFF_OMEM), *mg = (bf16*)(ws + OFF_MG), *hm = (bf16*)(ws + OFF_HMID); \
    bf16* actm = (bf16*)(ws + OFF_ACTM); (void)actm; float* mpart = (float*)(ws + OFF_MPART); float* xssA = (float*)(ws + OFF_XSS); float* xssB = (float*)(ws + OFF_XSS2); \
    (void)xb; (void)qn; (void)kn; (void)vT; (void)qm; (void)gt; (void)finT; (void)ym; (void)ona; (void)omem; (void)mg; (void)hm; (void)mpart; (void)xssA; (void)xssB
    if (IN(0)) { PHASE_BEGIN();
        const bool helpers_first = (bx & 1) != 0;
        auto run_helpers = [&]() {
        { const int tid = TID_OF(wave_s); bf16* dC = (bf16*)(ws + OFF_DFTC); bf16* dS = (bf16*)(ws + OFF_DFTS); float* tw = (float*)(ws + OFF_TW); const int gt_ = vcu * 512 + tid, GT = G * 512; const float isq = 0.08838834764831845f;
          for (int i = gt_; i < 128 * 128; i += GT) { const int aa = i >> 7, bb = i & 127; const int m = (aa * bb) & 127; const float ang = (float)m * (2.0f / 128.0f); dC[i] = (bf16)f2bf(cospif(ang) * isq); dS[i] = (bf16)f2bf(sinpif(ang) * isq); }
          for (int i = gt_; i < 16384; i += GT) { const float ang = (float)i * (2.0f / 16384.0f); tw[2 * i] = cospif(ang); tw[2 * i + 1] = sinpif(ang); }
          { float* rp = (float*)(ws + OFF_RPBP); const float* rpb_in = AIN(6);
            for (int i = gt_; i < 2 * 8 * 15 * 128; i += GT) { const int j = (i & 127) - 48, row = i >> 7; rp[i] = (j >= 0 && j < 31) ? rpb_in[row * 31 + j] * 1.4426950408889634f : 0.f; } } }
        { const int lane = TID_OF(wave_s) & 63;
        for (int m = gw; m < S; m += NGW) { const f32x4* xr = (const f32x4*)(AIN(0) + (size_t)m * D) + lane; float s = 0.f; u32x2* o = (u32x2*)(xb + (size_t)m * D) + lane;
#pragma unroll
            for (int j = 0; j < 8; ++j) { const f32x4 v = xr[64 * j]; s += (v.x * v.x + v.y * v.y) + (v.z * v.z + v.w * v.w); u32x2 w; w.x = pk2(v.x, v.y); w.y = pk2(v.z, v.w); o[64 * j] = w;
                int w8 = zero_i_(); w8 = __builtin_amdgcn_cvt_pk_fp8_f32(v.x, v.y, w8, false); w8 = __builtin_amdgcn_cvt_pk_fp8_f32(v.z, v.w, w8, true); ((int*)(ws + OFF_XB8 + (size_t)m * D))[lane + 64 * j] = w8; }
            s = wave_sum(s); if (lane < 32) xssA[(size_t)m * 32 + lane] = lane == 0 ? s : 0.f; } }
        { const int tid = TID_OF(wave_s); float* cs = (float*)(lds_raw); if (tid < 128) { const float ang = (float)tid * (2.0f / 128.0f); cs[tid] = cospif(ang); cs[128 + tid] = sinpif(ang); } __syncthreads();
          const float isq = 0.08838834764831845f;
          int tw_ = tid; asm volatile("" : "+v"(tw_));
          for (int it = vcu * 512 + tw_; it < 2 * 128 * 512; it += G * 512) {
              const int n4 = it & 511, k8 = (it >> 9) & 127, l = it >> 16; const int kk0 = k8 * 8, im = kk0 >= 512, g = (kk0 & 511) >> 7, c0 = kk0 & 127;
              const float* Wf = AIN(11) + (size_t)l * 512 * D + (size_t)(g * 128) * D + 4 * n4; const float* tb = cs + (im ? 128 : 0); const float sg = im ? -isq : isq;
              f32x4 acc8[8];
#pragma unroll
              for (int j = 0; j < 8; ++j) acc8[j] = (f32x4){0.f, 0.f, 0.f, 0.f};
              int mi[8];
#pragma unroll
              for (int j = 0; j < 8; ++j) mi[j] = 0;
              for (int cp0 = 0; cp0 < 128; cp0 += 16) { f32x4 w[16];
#pragma unroll
                  for (int q = 0; q < 16; ++q) w[q] = *(const f32x4*)(Wf + (size_t)(cp0 + q) * D);
#pragma unroll
                  for (int q = 0; q < 16; ++q)
#pragma unroll
                      for (int j = 0; j < 8; ++j) { acc8[j] += w[q] * tb[mi[j]]; mi[j] = (mi[j] + c0 + j) & 127; } }
              bf16* dstp = (bf16*)(ws + OFF_WALL + l * SZ_WALL) + (size_t)(4 * n4) * LDM + 1536 + kk0;
#pragma unroll
              for (int q = 0; q < 4; ++q) { u32x4 o; o.x = pk2(acc8[0][q] * sg, acc8[1][q] * sg); o.y = pk2(acc8[2][q] * sg, acc8[3][q] * sg); o.z = pk2(acc8[4][q] * sg, acc8[5][q] * sg); o.w = pk2(acc8[6][q] * sg, acc8[7][q] * sg);
                  *(u32x4*)(dstp + (size_t)q * LDM) = o; } }
          __syncthreads(); }
        for (int b = vcu; b < 256; b += G) { float* sm = (float*)lds_raw;
            float* red = sm + 512 * 16; float* srs = red + 8 * 16 * 128; float* sred = srs + 16;
            int t = TID_OF(wave_s); asm volatile("" : "+v"(t));
            const int l = b >> 7, ch = (b >> 4) & 7, rg = b & 15; const int cq = t & 31, kg = (t >> 5) & 7, rq = t >> 8; const int lane = t & 63;
            const float* mem = AIN(1) + (size_t)(rg * 16) * D; const float* g = AIN(7) + l * D; const float* W = AIN(8) + (size_t)l * D * 1024 + ch * 128 + 4 * cq;
            __syncthreads();
            for (int r = wave * 2; r < wave * 2 + 2; ++r) { float s = 0.f; for (int k = lane; k < D; k += 64) { const float v = mem[(size_t)r * D + k]; s += v * v; } s = wave_sum(s); if (lane == 0) srs[r] = 1.f / sqrtf(s * (1.f / D) + EPS); }
            f32x4 acc4[8];
#pragma unroll
            for (int j = 0; j < 8; ++j) acc4[j] = (f32x4){0.f, 0.f, 0.f, 0.f};
            for (int kc = 0; kc < D; kc += 512) {
                __syncthreads();
                for (int i = t; i < 16 * 512; i += 512) { const int r = i >> 9, k = i & 511; sm[k * 16 + r] = mem[(size_t)r * D + kc + k] * g[kc + k]; }
                __syncthreads();
                for (int k = kg * 64; k < kg * 64 + 64; k += 8) { f32x4 w[8];
#pragma unroll
                    for (int q = 0; q < 8; ++q) w[q] = *(const f32x4*)(W + (size_t)(kc + k + q) * 1024);
#pragma unroll
                    for (int q = 0; q < 8; ++q) { const f32x4 m0 = *(const f32x4*)(sm + (k + q) * 16 + 8 * rq), m1 = *(const f32x4*)(sm + (k + q) * 16 + 8 * rq + 4);
#pragma unroll
                        for (int j = 0; j < 4; ++j) { acc4[j] += w[q] * m0[j]; acc4[4 + j] += w[q] * m1[j]; } } } }
            __syncthreads();
#pragma unroll
            for (int j = 0; j < 8; ++j) *(f32x4*)(red + ((kg * 16 + rq * 8 + j) * 128) + 4 * cq) = acc4[j];
            __syncthreads();
            { const int col = t & 127, rq2 = t >> 7; float acc[4];
#pragma unroll
              for (int j = 0; j < 4; ++j) { const int r = rq2 * 4 + j; acc[j] = (((red[(0 * 16 + r) * 128 + col] + red[(1 * 16 + r) * 128 + col]) + (red[(2 * 16 + r) * 128 + col] + red[(3 * 16 + r) * 128 + col])) + ((red[(4 * 16 + r) * 128 + col] + red[(5 * 16 + r) * 128 + col]) + (red[(6 * 16 + r) * 128 + col] + red[(7 * 16 + r) * 128 + col]))) * srs[r]; }
              if (ch < 4) {
#pragma unroll
                  for (int j = 0; j < 4; ++j) { float s = wave_sum(acc[j] * acc[j]); if (lane == 0) sred[(rq2 * 4 + j) * 2 + (wave & 1)] = s; }
                  __syncthreads();
                  const float kg_ = AIN(10)[l * HD + col]; bf16* dst = (bf16*)(ws + OFF_KMEM) + ((size_t)(l * 4 + ch) * NMEM) * HD;
#pragma unroll
                  for (int j = 0; j < 4; ++j) { const int r = rq2 * 4 + j; const float ss = sred[r * 2] + sred[r * 2 + 1]; const float rn = 1.f / sqrtf(ss * (1.f / HD) + EPS); const int mrow = rg * 16 + r;
                      dst[((((size_t)(mrow >> 5) * 8 + (col >> 4)) * 64) + ((col >> 3) & 1) * 32 + prow32(mrow & 31)) * 8 + (col & 7)] = (bf16)f2bf(acc[j] * rn * kg_); }
              } else { bf16* dst = (bf16*)(ws + OFF_VMEMT) + ((size_t)(l * 4 + (ch - 4)) * HD) * NMEM;
#pragma unroll
                  for (int j = 0; j < 4; ++j) { const int mrow = rg * 16 + rq2 * 4 + j, o_ = mrow & 31; dst[(((((size_t)(mrow >> 5) * 4 + (col >> 5)) * 2 + (o_ >> 4)) * 64) + ((o_ >> 3) & 1) * 32 + (col & 31)) * 8 + (o_ & 7)] = (bf16)f2bf(acc[j]); } } }
            __syncthreads(); }
        };
        auto run_transposes = [&]() {
        const int lane = TID_OF(wave_s) & 63;
        { float* scr = (float*)lds_raw + wave * 64 * 33;
          constexpr int I_IN = (D / 64) * (INW / 32), I_NA = (1024 / 64) * (D / 32), I_MO = (512 / 64) * (D / 32), I_O = (D / 64) * (D / 32);
          constexpr int I_GU = (D / 64) * (DFF / 32), I_DN = (DFF / 64) * (D / 32); constexpr int PER_L = I_IN + I_NA + I_MO + I_O; constexpr int PER_F = 2 * I_GU + I_DN; constexpr int TOT = 2 * PER_L + PER_F * 9;
          struct Desc { const float* W; const float* gain; bf16* dst; bf16* dst2; int K, N, mode, item, ldk, koff, f8; };
          auto decode = [&](int it, Desc& d) { int r = it; d.gain = nullptr; d.dst2 = nullptr; d.ldk = 0; d.koff = 0; d.f8 = 0;
              if (r < 2 * PER_L) { const int l = r / PER_L; r -= l * PER_L;
                  if (r < I_IN) { d.W = AIN(3) + (size_t)l * D * INW; d.K = D; d.N = INW; d.gain = AIN(2) + l * D; d.dst = (bf16*)(ws + OFF_WINM + l * SZ_WINM); d.dst2 = (bf16*)(ws + OFF_WINT + l * SZ_WINT); d.mode = 1; d.item = r;
                      if ((r % (INW / 32)) * 32 >= 4096) { d.f8 = 1; d.mode = 4; d.dst = (bf16*)(ws + OFF_WINM + l * SZ_WINM + OFF_WG8); }
                      else if ((r % (INW / 32)) * 32 >= 2560 && (r % (INW / 32)) * 32 < 3584) { d.f8 = 1; d.mode = 5; d.dst = (bf16*)(ws + OFF_WINT + l * SZ_WINT); }
                      else if ((r % (INW / 32)) * 32 >= 512) { d.f8 = 1; d.mode = 6; }
                      return; } r -= I_IN;
                  if (r < I_NA) { d.W = AIN(12) + (size_t)l * 1024 * D; d.K = 1024; d.N = D; d.dst = (bf16*)(ws + OFF_WALL + l * SZ_WALL); d.ldk = LDM; d.koff = 0; d.mode = 0; d.item = r; return; } r -= I_NA;
                  if (r < I_MO) { d.W = AIN(13) + (size_t)l * 512 * D; d.K = 512; d.N = D; d.dst = (bf16*)(ws + OFF_WALL + l * SZ_WALL); d.ldk = LDM; d.koff = 1024; d.mode = 0; d.item = r; return; } r -= I_MO;
                  d.W = AIN(14) + (size_t)l * D * D; d.K = D; d.N = D; d.dst = (bf16*)(ws + OFF_WO + l * SZ_WO); d.mode = 0; d.item = r; d.f8 = (l == WO8_LAYER); return; }
              r -= 2 * PER_L; const int mm = r / PER_F; r -= mm * PER_F; d.f8 = mm > 0;
              bf16* dgu = (bf16*)(ws + (mm == 0 ? OFF_WGU0 : OFF_WGUE + (size_t)(mm - 1) * (SZ_WGU / 2))); bf16* dd = (bf16*)(ws + (mm == 0 ? OFF_WD0 : OFF_WDE + (size_t)(mm - 1) * (SZ_WD / 2)));
              if (r < I_GU) { d.W = mm == 0 ? AIN(16) : AIN(20) + (size_t)(mm - 1) * D * DFF; d.K = D; d.N = DFF; d.gain = AIN(15) + (mm == 0 ? 0 : D); d.dst = dgu; d.mode = 2; d.item = r; return; } r -= I_GU;
              if (r < I_GU) { d.W = mm == 0 ? AIN(17) : AIN(21) + (size_t)(mm - 1) * D * DFF; d.K = D; d.N = DFF; d.gain = AIN(15) + (mm == 0 ? 0 : D); d.dst = dgu; d.mode = 3; d.item = r; return; } r -= I_GU;
              d.W = mm == 0 ? AIN(18) : AIN(22) + (size_t)(mm - 1) * DFF * D; d.K = DFF; d.N = D; d.dst = dd; d.mode = 0; d.item = r; };
          auto fin = [&](const Desc& dc, const TrLoad& tc, int sub) { const int item = dc.item + sub;
              if (dc.f8) { if (dc.mode == 4) transpose_finish8<4>(tc, dc.K, dc.N, dc.gain, 64.f, (unsigned char*)dc.dst, scr, item, lane); else if (dc.mode == 5) transpose_finish8<5>(tc, dc.K, dc.N, dc.gain, 64.f, (unsigned char*)dc.dst, scr, item, lane); else if (dc.mode == 6) transpose_finish8<6>(tc, dc.K, dc.N, dc.gain, 64.f, (unsigned char*)dc.dst, scr, item, lane); else if (dc.mode == 0) transpose_finish8<0>(tc, dc.K, dc.N, dc.gain, 64.f, (unsigned char*)dc.dst, scr, item, lane); else if (dc.mode == 2) transpose_finish8<2>(tc, dc.K, dc.N, dc.gain, 64.f, (unsigned char*)dc.dst, scr, item, lane); else transpose_finish8<3>(tc, dc.K, dc.N, dc.gain, 64.f, (unsigned char*)dc.dst, scr, item, lane); }
              else if (dc.mode == 0) transpose_finish<0>(tc, dc.K, dc.N, dc.gain, dc.dst, dc.dst2, scr, item, lane, dc.ldk, dc.koff);
              else if (dc.mode == 1) transpose_finish<1>(tc, dc.K, dc.N, dc.gain, dc.dst, dc.dst2, scr, item, lane);
              else if (dc.mode == 2) transpose_finish<2>(tc, dc.K, dc.N, dc.gain, dc.dst, dc.dst2, scr, item, lane);
              else transpose_finish<3>(tc, dc.K, dc.N, dc.gain, dc.dst, dc.dst2, scr, item, lane); };
          for (int it4r = gw; it4r < TOT / 4; it4r += NGW) { const int it4 = TOT / 4 - 1 - it4r; Desc d; decode(it4 * 4, d);
              TrLoad t4[4]; transpose_load4(d.W, d.N, d.item >> 2, lane, t4);
              fin(d, t4[0], 0); fin(d, t4[1], 1); fin(d, t4[2], 2); fin(d, t4[3], 3); }
          __syncthreads(); }
        };
        (void)helpers_first; run_transposes(); run_helpers();
    }
    SEAM(0);

    for (int l = 0; l < 2; ++l) {
        const int pb = 1 + 8 * l;
        if (IN(pb + 0)) { PHASE_BEGIN(); float* xss_in = xssA;
            { pg8::Sched<0> Sd{(const char*)(ws + OFF_XB8), (const char*)(ws + OFF_WINM + l * SZ_WINM + OFF_WG8), D / 2, (unsigned)(D / 2), (unsigned)(D / 2), S / 256, 6144 / 256, G, bx, nullptr, 0, nullptr};
              pg8::EpGates8 E{xss_in, (unsigned char*)gt}; pg8::gemm_phase(lds, Sd, E, wave_s); }
            { pg8::Sched<0> Sd{(const char*)(ws + OFF_XB8), (const char*)(ws + OFF_WINM + l * SZ_WINM), D / 2, (unsigned)(D / 2), (unsigned)(D / 2), S / 256, 2560 / 256, G, bx, nullptr, 0, nullptr};
              pg8::EpInMain<true> E{xss_in, qn, kn, qm, AIN(4) + l * HD, AIN(5) + l * HD, AIN(9) + l * HD};
              pg8::gemm_phase(lds, Sd, E, wave_s); }
            { pg8::Sched<0> Sd{(const char*)(ws + OFF_WINT + l * SZ_WINT), (const char*)(ws + OFF_XB8), D / 2, (unsigned)(D / 2), (unsigned)(D / 2), 1024 / 256, S / 256, G, bx, nullptr, 0, nullptr};
              pg8::EpT<0, true> E{xss_in, vT}; pg8::gemm_phase(lds, Sd, E, wave_s); }
            { pg8::Sched<1> Sd{(const char*)(ws + OFF_WINT + l * SZ_WINT) + (size_t)1024 * D * 2, (const char*)xb, D, (unsigned)D, (unsigned)D, 512 / 256, S / 256, G, (bx + G / 2) % G, nullptr, 0, nullptr};
              pg8::EpT<1> E{xss_in, finT}; pg8::gemm_phase(lds, Sd, E, wave_s); }
        }
        SEAM(pb + 0);
        if (IN(pb + 1)) { PHASE_BEGIN();
            unsigned* f1cnt = ctl + CW_F1 + 64 * l;
            { const int lane = TID_OF(wave_s) & 63; for (int u = gw; u < 2048; u += NGW) f1_wave(finT, (const bf16*)(ws + OFF_DFTC), (const bf16*)(ws + OFF_DFTS), (const float*)(ws + OFF_TW), (bf16*)(ws + OFF_B2P), (bf16*)(ws + OFF_B2Q), u, lane); }
            asm volatile("s_waitcnt vmcnt(0)" ::: "memory");
            __syncthreads();
            if (wave_s == 0 && lane_id_() == 0) { __builtin_amdgcn_fence(__ATOMIC_RELEASE, "agent"); asm volatile("s_waitcnt vmcnt(0)" ::: "memory");
                (void)__hip_atomic_fetch_add((GAS unsigned*)f1cnt, 1u, __ATOMIC_RELAXED, __HIP_MEMORY_SCOPE_AGENT); }
            { const int lane = TID_OF(wave_s) & 63;
            for (int u = gw; u < ROWS * 8 * 2; u += NGW) { const int half = u & 1, hd = (u >> 1) & 7, qr = u >> 4; int rstart = qr - 4; rstart = rstart < 0 ? 0 : (rstart > ROWS - 8 ? ROWS - 8 : rstart); const int tok0 = qr * GW + half * 32;
                attn_wave_f<true>(qn + (size_t)tok0 * 1024 + hd * HD, 1024, kn + (size_t)hd * 512 * 4096, vT + (size_t)hd * 512 * 4096, 2 * rstart, 16, (const float*)(ws + OFF_RPBP) + ((size_t)(l * 8 + hd)) * 15 * 128, qr, rstart, half, actm + (size_t)tok0 * LDM + hd * HD, LDM, lane); } }
            { const int lane = TID_OF(wave_s) & 63;
            for (int u = gw; u < (S / 32) * 4; u += NGW) { const int hd = u & 3, qb = u >> 2; const int tok0 = qb * 32;
                const bf16* km = (const bf16*)(ws + OFF_KMEM) + (size_t)(l * 4 + hd) * NMEM * HD; const bf16* vm = (const bf16*)(ws + OFF_VMEMT) + (size_t)(l * 4 + hd) * HD * NMEM;
                attn_wave_f<false>(qm + (size_t)tok0 * 512 + hd * HD, 512, km, vm, 0, 8, nullptr, 0, 0, 0, actm + (size_t)tok0 * LDM + 1024 + hd * HD, LDM, lane); } }
            if (wave_s == 0) {
                if (lane_id_() == 0) { unsigned sp = 0; while (__hip_atomic_load((GAS unsigned*)f1cnt, __ATOMIC_RELAXED, __HIP_MEMORY_SCOPE_AGENT) < (unsigned)G) { __builtin_amdgcn_s_sleep(2); if (++sp > (1u << 20)) break; } }
                __builtin_amdgcn_fence(__ATOMIC_ACQUIRE, "agent"); asm volatile("s_waitcnt vmcnt(0)" ::: "memory"); }
            __syncthreads();
            { const int lane = TID_OF(wave_s) & 63; for (int u = gw; u < 2048; u += NGW) f2_wave((const bf16*)(ws + OFF_B2P), (const bf16*)(ws + OFF_B2Q), (const bf16*)(ws + OFF_DFTC), (const bf16*)(ws + OFF_DFTS), actm + 1536, u, lane, LDM); }
        }
        if (IN(pb + 1) && IN(pb + 3)) xcd_barrier(bar);
        if (IN(pb + 3)) { PHASE_BEGIN(); pg8::Sched<0> Sd{(const char*)actm, (const char*)(ws + OFF_WALL + l * SZ_WALL), LDM, (unsigned)LDM, (unsigned)LDM, S / 256, D / 256, G, bx, nullptr, 0, nullptr}; if (l == WO8_LAYER) { pg8::EpMerge<true> E{(const unsigned char*)gt, mg}; pg8::gemm_phase(lds, Sd, E, wave_s); } else { pg8::EpMerge<false> E{(const unsigned char*)gt, mg}; pg8::gemm_phase(lds, Sd, E, wave_s); } }
        SEAM(pb + 3);
        if (IN(pb + 4)) { PHASE_BEGIN(); const int kk = (l == WO8_LAYER) ? D / 2 : D;
            pg8::Sched<0> Sd{(const char*)mg, (const char*)(ws + OFF_WO + l * SZ_WO), kk, (unsigned)kk, (unsigned)kk, S / 256, D / 256, G, bx, nullptr, 0, nullptr};
            if (l == 0) { if (WO8_LAYER == 0) { pg8::EpRes<0, 1024> E{xb, xssB, nullptr}; pg8::gemm_phase(lds, Sd, E, wave_s); } else { pg8::EpRes<0> E{xb, xssB, nullptr}; pg8::gemm_phase(lds, Sd, E, wave_s); } }
            else { if (WO8_LAYER == 1) { pg8::EpRes<1, 1024> E{xb, nullptr, ws + OFF_XB8}; pg8::gemm_phase(lds, Sd, E, wave_s); } else { pg8::EpRes<1> E{xb, nullptr, ws + OFF_XB8}; pg8::gemm_phase(lds, Sd, E, wave_s); } } }
        if (l == 0) {
            if (IN(pb + 4) && IN(pb + 6)) xcd_barrier(bar);
            if (IN(pb + 6)) { PHASE_BEGIN(); pg8::Sched<0> Sd{(const char*)xb, (const char*)(ws + OFF_WGU0), D, (unsigned)D, (unsigned)D, S / 256, 2 * DFF / 256, G, bx, nullptr, 0, nullptr};
                pg8::EpGU<0> E{xssB, nullptr, nullptr, hm, mt}; pg8::gemm_phase(lds, Sd, E, wave_s); }
            SEAM(pb + 6);
            if (IN(pb + 7)) { PHASE_BEGIN(); pg8::Sched<0> Sd{(const char*)hm, (const char*)(ws + OFF_WD0), DFF, (unsigned)DFF, (unsigned)DFF, S / 256, D / 256, G, bx, nullptr, 0, nullptr};
                pg8::EpRes<1> E{xb, xssA, ws + OFF_XB8}; pg8::gemm_phase(lds, Sd, E, wave_s); }
            SEAM(pb + 7);
        } else {
            SEAM(pb + 4);
            if (IN(pb + 5)) { PHASE_BEGIN();
                const float* g = AIN(15) + D; const float* wr_ = AIN(19); unsigned* cnt = ctl + CW_CNT; int* tokl = (int*)(ws + OFF_TOKL); float* wtl = (float*)(ws + OFF_WTL); float* rst = (float*)(ws + OFF_RSTOK);
                LAS f32x4* wA = (LAS f32x4*)lds; LAS f32x4* wB = wA + 2048;
                for (int k = tid; k < D; k += 512) { const float gk = g[k]; const f32x4 w0 = *(const f32x4*)(wr_ + (size_t)k * 8) * gk, w1 = *(const f32x4*)(wr_ + (size_t)k * 8 + 4) * gk; const int p = (k & 3) * 512 + (k >> 2); wA[p] = w0; wB[p] = w1; }
                __syncthreads();
                for (int t = gw; t < S; t += NGW) { const bf16* xr = xb + (size_t)t * D; float ss = 0.f; float lg[8] = {0, 0, 0, 0, 0, 0, 0, 0};
#pragma unroll
                    for (int j = 0; j < 8; ++j) { const int k0 = 4 * lane + 256 * j; const f32x4 xv = pg8::bf4_to_f32(*(const u32x2*)(xr + k0));
#pragma unroll
                        for (int e4 = 0; e4 < 4; ++e4) { const float xg = xv[e4]; ss += xg * xg; const f32x4 w0 = wA[e4 * 512 + lane + 64 * j], w1 = wB[e4 * 512 + lane + 64 * j];
                            lg[0] += xg * w0[0]; lg[1] += xg * w0[1]; lg[2] += xg * w0[2]; lg[3] += xg * w0[3]; lg[4] += xg * w1[0]; lg[5] += xg * w1[1]; lg[6] += xg * w1[2]; lg[7] += xg * w1[3]; } }
                    ss = wave_sum(ss); const float rs = 1.f / sqrtf(ss * (1.f / D) + EPS);
#pragma unroll
                    for (int e = 0; e < 8; ++e) lg[e] = wave_sum(lg[e]) * rs;
                    int e0 = 0; float l0 = lg[0];
#pragma unroll
                    for (int e = 1; e < 8; ++e) if (lg[e] > l0) { l0 = lg[e]; e0 = e; }
                    int e1 = 0; float l1 = -3.0e38f;
#pragma unroll
                    for (int e = 0; e < 8; ++e) if (e != e0 && lg[e] > l1) { l1 = lg[e]; e1 = e; }
                    const float w1 = 1.f / (1.f + __expf(l0 - l1)), w0 = 1.f - w1;
                    if (lane == 0) { rst[t] = rs; unsigned s0 = atomicAdd(cnt + e0, 1u); tokl[e0 * CAP + s0] = t; unsigned s1 = atomicAdd(cnt + e1, 1u); tokl[e1 * CAP + s1] = t; wtl[e0 * CAP + s0] = rs; wtl[e1 * CAP + s1] = rs;
                        int* tsl = (int*)(ws + OFF_TOKSLOT); float* tw_ = (float*)(ws + OFF_TOKW); tsl[2 * t] = e0 * CAP + (int)s0; tsl[2 * t + 1] = e1 * CAP + (int)s1; tw_[2 * t] = w0; tw_[2 * t + 1] = w1; } }
            }
            SEAM(pb + 5);
            if (IN(pb + 6)) { PHASE_BEGIN(); moe_tables(mt, ctl + CW_CNT, tid);
                pg8::Sched<2> Sd{(const char*)(ws + OFF_XB8), (const char*)(ws + OFF_WGUE), D / 2, (unsigned)(D / 2), (unsigned)(D / 2), 0, 2 * DFF / 256, G, bx, (const int*)(ws + OFF_TOKL), SZ_WGU / 2, mt};
                pg8::EpGU8 E{(const float*)(ws + OFF_WTL), (const int*)(ws + OFF_TOKL), (unsigned char*)hm, mt}; pg8::gemm_phase(lds, Sd, E, wave_s); }
            SEAM(pb + 6);
            if (IN(pb + 7)) { PHASE_BEGIN(); moe_tables(mt, ctl + CW_CNT, tid);
                pg8::Sched<3> Sd{(const char*)hm, (const char*)(ws + OFF_WDE), DFF / 2, (unsigned)(DFF / 2), (unsigned)(DFF / 2), 0, D / 256, G, bx, (const int*)(ws + OFF_TOKL), SZ_WD / 2, mt};
                pg8::EpMoeY E{(bf16*)(ws + OFF_YBUF)}; pg8::gemm_phase(lds, Sd, E, wave_s); }
            SEAM(pb + 7);
            if (IN(pb + 8)) { PHASE_BEGIN();
                const unsigned* cnt = ctl + CW_CNT; const int* tsl = (const int*)(ws + OFF_TOKSLOT); const float* tw_ = (const float*)(ws + OFF_TOKW); const bf16* yb = (const bf16*)(ws + OFF_YBUF); float* outp = AOUT;
                int tstart[8]; { int ts = 0;
#pragma unroll
                    for (int e = 0; e < 8; ++e) { tstart[e] = ts; ts += ((int)cnt[e] + 255) >> 8; } }
                for (int t = gw; t < S; t += NGW) { const int v0 = tsl[2 * t], v1 = tsl[2 * t + 1]; const float w0 = tw_[2 * t], w1 = tw_[2 * t + 1];
                    const int e0 = v0 >> 14, e1 = v1 >> 14; int ts0 = 0, ts1 = 0;
#pragma unroll
                    for (int e = 0; e < 8; ++e) { ts0 = (e == e0) ? tstart[e] : ts0; ts1 = (e == e1) ? tstart[e] : ts1; }
                    const bf16* y0 = yb + (size_t)(256 * ts0 + (v0 & 16383)) * D; const bf16* y1 = yb + (size_t)(256 * ts1 + (v1 & 16383)) * D; float* o = outp + (size_t)t * D; const bf16* hx = xb + (size_t)t * D;
#pragma unroll
                    for (int j = 0; j < 8; ++j) { const int c = 4 * lane + 256 * j; f32x4 x = pg8::bf4_to_f32(*(const u32x2*)(hx + c)); const f32x4 a = pg8::bf4_to_f32(*(const u32x2*)(y0 + c)), b2 = pg8::bf4_to_f32(*(const u32x2*)(y1 + c));
                        x = x + a * w0 + b2 * w1; *(f32x4*)(o + c) = x; } }
            }
        }
    }
#undef IN
#undef SEAM
}

#ifndef MK_PER_PHASE
#define MK_PER_PHASE 0
#endif
extern "C" void kernel_launch(void* const* d_in, const int* in_sizes, int n_in, void* d_out, int out_size, void* d_ws, size_t ws_size, hipStream_t stream) {
    if (n_in != 23 || out_size != S * D || ws_size < WS_NEED) { fprintf(stderr, "kernel_launch: unexpected shapes/ws (%d inputs, out %d, ws %zu, need %zu)\n", n_in, out_size, ws_size, (size_t)WS_NEED); return; }
    static int grid = 0;
    if (grid == 0) { int dev = 0, cus = 0;
        if (hipGetDevice(&dev) != hipSuccess || hipDeviceGetAttribute(&cus, hipDeviceAttributeMultiprocessorCount, dev) != hipSuccess) { grid = -1; return; }
        if (hipFuncSetAttribute((const void*)mega, hipFuncAttributeMaxDynamicSharedMemorySize, LDS_BYTES) != hipSuccess) { fprintf(stderr, "kernel_launch: hipFuncSetAttribute failed\n"); grid = -1; return; }
        int per_cu = 0; (void)hipOccupancyMaxActiveBlocksPerMultiprocessor(&per_cu, (const void*)mega, 512, LDS_BYTES); (void)hipGetLastError();
        if (per_cu < 1) fprintf(stderr, "kernel_launch: occupancy query reports %d blocks per CU\n", per_cu);
        grid = cus; }
    if (grid < 0) return;
    (void)hipMemsetAsync((char*)d_ws + OFF_CTL, 0, MiB, stream);
    MArgs a{}; for (int i = 0; i < 23; ++i) a.ptr[i] = d_in[i]; a.ptr[23] = d_out; a.ptr[24] = d_ws;
#if MK_PER_PHASE
    { int li = 0; for (int ph = 0; ph < NPHASE; ++ph) { if (ph == 6 || ph == 3 || ph == 11) continue; a.ph_lo = ph; a.ph_hi = ph + 1; a.li = li++; hipLaunchKernelGGL(mega, dim3(grid), dim3(512), LDS_BYTES, stream, a); } }
#elif defined(MK_DUP_MASK)
    { int li = 0, lo = 0;
      for (int ph = 0; ph < NPHASE; ++ph) if ((MK_DUP_MASK >> ph) & 1) {
          a.ph_lo = lo; a.ph_hi = ph + 1; a.li = li++; hipLaunchKernelGGL(mega, dim3(grid), dim3(512), LDS_BYTES, stream, a);
          a.ph_lo = ph; a.ph_hi = ph + 1; a.li = li++; hipLaunchKernelGGL(mega, dim3(grid), dim3(512), LDS_BYTES, stream, a);
          lo = ph + 1; }
      if (lo < NPHASE) { a.ph_lo = lo; a.ph_hi = NPHASE; a.li = li++; hipLaunchKernelGGL(mega, dim3(grid), dim3(512), LDS_BYTES, stream, a); } }
#elif defined(MK_DUP_LO)
    a.ph_lo = 0; a.ph_hi = MK_DUP_HI + 1; a.li = 0; hipLaunchKernelGGL(mega, dim3(grid), dim3(512), LDS_BYTES, stream, a);
    a.ph_lo = MK_DUP_LO; a.ph_hi = MK_DUP_HI + 1; a.li = 1; hipLaunchKernelGGL(mega, dim3(grid), dim3(512), LDS_BYTES, stream, a);
    if (MK_DUP_HI + 1 < NPHASE) { a.ph_lo = MK_DUP_HI + 1; a.ph_hi = NPHASE; a.li = 2; hipLaunchKernelGGL(mega, dim3(grid), dim3(512), LDS_BYTES, stream, a); }
#else
    a.ph_lo = 0; a.ph_hi = NPHASE; a.li = 0; hipLaunchKernelGGL(mega, dim3(grid), dim3(512), LDS_BYTES, stream, a);
#endif
}
```
